# Optimizing an MI355X kernel written in HIP

```python
import jax, jax.numpy as jnp
from jax import lax
import numpy as np

D_MODEL = 1024
BATCH = 8
SEQ = 4096
DEPTH = 2

N_A = DEPTH // 2
N_B = DEPTH - N_A
N_META = 16
POOL_WINDOWS = (2, 4, 8, 16)
N_POOL_GROUPS = len(POOL_WINDOWS)
POOL_GROUP_DIM = D_MODEL // N_POOL_GROUPS
MAX_WINDOW = max(POOL_WINDOWS)
N_HEADS = 8
QK_NOPE_DIM = 128
QK_ROPE_DIM = 64
V_HEAD_DIM = 128
Q_LORA_RANK = 384
KV_LORA_RANK = 256
ROPE_THETA = 10000.0
ATTN_SCALE = (QK_NOPE_DIM + QK_ROPE_DIM) ** -0.5
Q_BLOCK = 128
N_EXPERT_GROUPS = 4
EXPERTS_PER_GROUP = 8
N_EXPERTS = N_EXPERT_GROUPS * EXPERTS_PER_GROUP
TOP_K_IN_GROUP = 2
D_EXPERT = 256
MOE_GROUP_ROWS = 256
RMS_EPS = 1e-6
NEG_INF = -1e30

kernel_name = "yoco_pool_mla_hier_moe"


def rmsnorm(x, g):
    xf = x.astype(jnp.float32)
    y = xf * lax.rsqrt(jnp.mean(xf * xf, axis=-1, keepdims=True) + RMS_EPS)
    return (y * g.astype(jnp.float32)).astype(x.dtype)


def rope_tables(length):
    pos = jnp.arange(length, dtype=jnp.float32)
    inv_freq = ROPE_THETA ** (-jnp.arange(0, QK_ROPE_DIM, 2, dtype=jnp.float32) / QK_ROPE_DIM)
    ang = pos[:, None] * inv_freq[None, :]
    return jnp.cos(ang), jnp.sin(ang)


def apply_rope(x, cos, sin):
    xf = x.astype(jnp.float32)
    half = xf.shape[-1] // 2
    x1, x2 = xf[..., :half], xf[..., half:]
    return jnp.concatenate([x1 * cos - x2 * sin, x1 * sin + x2 * cos], axis=-1).astype(x.dtype)


def pool_mixer(h, w_grp, scale):
    L_ = h.shape[1]
    hf = h.astype(jnp.float32)
    cs = jnp.pad(jnp.cumsum(hf, axis=1), ((0, 0), (MAX_WINDOW, 0), (0, 0)))
    t = jnp.arange(L_)
    outs = []
    for g, w in enumerate(POOL_WINDOWS):
        sl = slice(g * POOL_GROUP_DIM, (g + 1) * POOL_GROUP_DIM)
        win_sum = cs[:, MAX_WINDOW:, sl] - cs[:, MAX_WINDOW - w:MAX_WINDOW - w + L_, sl]
        cnt = jnp.minimum(t + 1, w).astype(jnp.float32)[None, :, None]
        pooled = (win_sum / cnt - hf[:, :, sl]).astype(h.dtype)
        outs.append(jnp.einsum('blc,cd->bld', pooled, w_grp[g]))
    return jnp.concatenate(outs, axis=-1) * scale


def shared_latent_kv(h, kv_norm, w_dkv, kv_lat_norm, w_uk, w_uv, cos, sin):
    c = jnp.einsum('bld,dr->blr', rmsnorm(h, kv_norm), w_dkv)
    c_kv = rmsnorm(c[..., :KV_LORA_RANK], kv_lat_norm)
    k_rope = apply_rope(c[..., KV_LORA_RANK:], cos, sin)
    k_nope = jnp.einsum('blr,rhd->blhd', c_kv, w_uk)
    v = jnp.einsum('blr,rhd->blhd', c_kv, w_uv)
    return k_nope, k_rope, v


def causal_block_attention(q_nope, q_rope, k_nope, k_rope, v):
    B_, L_, H_, _ = q_nope.shape
    nb = -(-L_ // Q_BLOCK)
    Lp = nb * Q_BLOCK
    pad = Lp - L_
    padf = lambda a: jnp.pad(a, [(0, 0), (0, pad)] + [(0, 0)] * (a.ndim - 2))
    qn, qr, kn, kr, vv = padf(q_nope), padf(q_rope), padf(k_nope), padf(k_rope), padf(v)
    to_blocks = lambda a: jnp.moveaxis(a.reshape((B_, nb, Q_BLOCK) + a.shape[2:]), 1, 0)
    kpos = jnp.arange(Lp)

    def one_block(args):
        qn_b, qr_b, b_idx = args
        s = (jnp.einsum('bqhd,bkhd->bhqk', qn_b, kn, preferred_element_type=jnp.float32)
             + jnp.einsum('bqhr,bkr->bhqk', qr_b, kr, preferred_element_type=jnp.float32)) * ATTN_SCALE
        qpos = b_idx * Q_BLOCK + jnp.arange(Q_BLOCK)
        s = jnp.where(kpos[None, :] <= qpos[:, None], s, NEG_INF)
        p = jax.nn.softmax(s, axis=-1)
        return jnp.einsum('bhqk,bkhd->bqhd', p.astype(vv.dtype), vv)

    o = lax.map(one_block, (to_blocks(qn), to_blocks(qr), jnp.arange(nb)))
    return jnp.moveaxis(o, 0, 1).reshape(B_, Lp, H_, V_HEAD_DIM)[:, :L_]


def mla_mixer(hn, w_dq, q_norm, w_uq, w_o, k_nope, k_rope, v, cos, sin):
    B_, L_, _ = hn.shape
    cq = rmsnorm(jnp.einsum('bld,dr->blr', hn, w_dq), q_norm)
    q = jnp.einsum('blr,rhd->blhd', cq, w_uq)
    q_nope = q[..., :QK_NOPE_DIM]
    q_rope = apply_rope(q[..., QK_NOPE_DIM:], cos[:, None, :], sin[:, None, :])
    o = causal_block_attention(q_nope, q_rope, k_nope, k_rope, v)
    return jnp.einsum('blf,fd->bld', o.reshape(B_, L_, N_HEADS * V_HEAD_DIM), w_o)


def hierarchical_moe(h, wr_g, br_g, wr_e, br_e, w_gate, w_up, w_down):
    B_, L_, D_ = h.shape
    xt = h.reshape(-1, D_)
    n_tok = xt.shape[0]
    xf = xt.astype(jnp.float32)
    p_g = jax.nn.softmax(xf @ wr_g.astype(jnp.float32) + br_g.astype(jnp.float32), axis=-1)
    g_sel = jnp.argmax(p_g, axis=-1)
    w_g = jnp.max(p_g, axis=-1)
    logit_e = (xf @ wr_e.astype(jnp.float32) + br_e.astype(jnp.float32)).reshape(n_tok, N_EXPERT_GROUPS, EXPERTS_PER_GROUP)
    sel = jnp.take_along_axis(logit_e, g_sel[:, None, None], axis=1)[:, 0]
    top_v, top_i = lax.top_k(sel, TOP_K_IN_GROUP)
    gate = w_g[:, None] * jax.nn.softmax(top_v, axis=-1)
    eid = (g_sel[:, None] * EXPERTS_PER_GROUP + top_i).reshape(-1).astype(jnp.int32)
    tid = jnp.repeat(jnp.arange(n_tok, dtype=jnp.int32), TOP_K_IN_GROUP)
    wt = gate.reshape(-1)
    n_assign = n_tok * TOP_K_IN_GROUP
    order = jnp.argsort(eid)
    e_sorted = eid[order]
    counts = jnp.bincount(eid, length=N_EXPERTS)
    starts = jnp.cumsum(counts) - counts
    padded = (counts + MOE_GROUP_ROWS - 1) // MOE_GROUP_ROWS * MOE_GROUP_ROWS
    pends = jnp.cumsum(padded)
    pstarts = pends - padded
    dest = pstarts[e_sorted] + (jnp.arange(n_assign) - starts[e_sorted])
    n_blocks = -(-(n_assign + N_EXPERTS * (MOE_GROUP_ROWS - 1)) // MOE_GROUP_ROWS)
    n_rows = n_blocks * MOE_GROUP_ROWS
    row_tok = jnp.full((n_rows,), n_tok, jnp.int32).at[dest].set(tid[order])
    row_w = jnp.zeros((n_rows,), h.dtype).at[dest].set(wt[order].astype(h.dtype))
    block_e = jnp.minimum(jnp.searchsorted(pends, jnp.arange(n_blocks) * MOE_GROUP_ROWS, side='right'), N_EXPERTS - 1)
    x_rows = jnp.concatenate([xt, jnp.zeros((1, D_), xt.dtype)], axis=0)[row_tok]
    x_rows = x_rows.reshape(n_blocks, MOE_GROUP_ROWS, D_)

    def expert_block(args):
        e, xb = args
        return (jax.nn.silu(xb @ w_gate[e]) * (xb @ w_up[e])) @ w_down[e]

    y = lax.map(expert_block, (block_e, x_rows)).reshape(n_rows, D_)
    out = jnp.zeros((n_tok + 1, D_), h.dtype).at[row_tok].add(y * row_w[:, None])[:n_tok]
    return out.reshape(B_, L_, D_)


def setup_inputs(seed: int = 0) -> dict:
    key = jax.random.key(seed)
    ks = jax.random.split(key, 32)
    f32 = jnp.float32
    nrm = lambda k, shape, fan: jax.random.normal(k, shape, f32) * (fan ** -0.5)
    gain = lambda k, shape: 1.0 + 0.05 * jax.random.normal(k, shape, f32)
    return {
        "x": jax.random.normal(ks[0], (BATCH, SEQ, D_MODEL), f32),
        "meta_tokens": jax.random.normal(ks[1], (N_META, D_MODEL), f32),
        "a_norm": gain(ks[2], (N_A, D_MODEL)),
        "a_w": nrm(ks[3], (N_A, N_POOL_GROUPS, POOL_GROUP_DIM, POOL_GROUP_DIM), POOL_GROUP_DIM),
        "a_scale": gain(ks[4], (N_A, D_MODEL)),
        "b_norm": gain(ks[5], (N_B, D_MODEL)),
        "b_w_dq": nrm(ks[6], (N_B, D_MODEL, Q_LORA_RANK), D_MODEL),
        "b_q_norm": gain(ks[7], (N_B, Q_LORA_RANK)),
        "b_w_uq": nrm(ks[8], (N_B, Q_LORA_RANK, N_HEADS, QK_NOPE_DIM + QK_ROPE_DIM), Q_LORA_RANK),
        "b_w_o": nrm(ks[9], (N_B, N_HEADS * V_HEAD_DIM, D_MODEL), N_HEADS * V_HEAD_DIM),
        "kv_norm": gain(ks[10], (D_MODEL,)),
        "w_dkv": nrm(ks[11], (D_MODEL, KV_LORA_RANK + QK_ROPE_DIM), D_MODEL),
        "kv_lat_norm": gain(ks[12], (KV_LORA_RANK,)),
        "w_uk": nrm(ks[13], (KV_LORA_RANK, N_HEADS, QK_NOPE_DIM), KV_LORA_RANK),
        "w_uv": nrm(ks[14], (KV_LORA_RANK, N_HEADS, V_HEAD_DIM), KV_LORA_RANK),
        "ffn_norm": gain(ks[15], (DEPTH, D_MODEL)),
        "router_g": nrm(ks[16], (DEPTH, D_MODEL, N_EXPERT_GROUPS), D_MODEL),
        "router_g_bias": 0.01 * jax.random.normal(ks[17], (DEPTH, N_EXPERT_GROUPS), f32),
        "router_e": nrm(ks[18], (DEPTH, D_MODEL, N_EXPERTS), D_MODEL),
        "router_e_bias": 0.01 * jax.random.normal(ks[19], (DEPTH, N_EXPERTS), f32),
        "w_gate": nrm(ks[20], (DEPTH, N_EXPERTS, D_MODEL, D_EXPERT), D_MODEL),
        "w_up": nrm(ks[21], (DEPTH, N_EXPERTS, D_MODEL, D_EXPERT), D_MODEL),
        "w_down": nrm(ks[22], (DEPTH, N_EXPERTS, D_EXPERT, D_MODEL), D_EXPERT),
        "final_norm": gain(ks[23], (D_MODEL,)),
    }


def reference(x, meta_tokens, a_norm, a_w, a_scale, b_norm, b_w_dq, b_q_norm, b_w_uq, b_w_o,
              kv_norm, w_dkv, kv_lat_norm, w_uk, w_uv, ffn_norm, router_g, router_g_bias,
              router_e, router_e_bias, w_gate, w_up, w_down, final_norm):
    B_, S_, D_ = x.shape
    h = jnp.concatenate([jnp.broadcast_to(meta_tokens[None].astype(x.dtype), (B_, N_META, D_)), x], axis=1)
    L_ = S_ + N_META
    cos, sin = rope_tables(L_)
    k_nope = k_rope = v = None
    for layer in range(DEPTH):
        if layer < N_A:
            i = layer
            h = h + pool_mixer(rmsnorm(h, a_norm[i]), a_w[i], a_scale[i])
        else:
            i = layer - N_A
            h = h + mla_mixer(rmsnorm(h, b_norm[i]), b_w_dq[i], b_q_norm[i], b_w_uq[i], b_w_o[i],
                              k_nope, k_rope, v, cos, sin)
        h = h + hierarchical_moe(rmsnorm(h, ffn_norm[layer]), router_g[layer], router_g_bias[layer],
                                 router_e[layer], router_e_bias[layer], w_gate[layer], w_up[layer], w_down[layer])
        if layer == N_A - 1:
            k_nope, k_rope, v = shared_latent_kv(h, kv_norm, w_dkv, kv_lat_norm, w_uk, w_uv, cos, sin)
    return rmsnorm(h, final_norm)[:, N_META:]
```

```cpp
#include <hip/hip_runtime.h>
#include <stdint.h>
#include <stdio.h>

#ifndef NAIVE_GEMM
#define NAIVE_GEMM 0
#endif
#ifndef NAIVE_ATTN
#define NAIVE_ATTN 0
#endif
#ifndef ONE_LAUNCH
#define ONE_LAUNCH 1
#endif

typedef unsigned short bf16_t;
typedef short bf16x8 __attribute__((ext_vector_type(8)));
typedef float f32x4 __attribute__((ext_vector_type(4)));
typedef float f32x2 __attribute__((ext_vector_type(2)));
typedef unsigned u32x4 __attribute__((ext_vector_type(4)));
typedef unsigned u32x2 __attribute__((ext_vector_type(2)));
#define DEV __device__ __forceinline__

constexpr int D = 1024, NB = 8, SEQ = 4096, NREAL = NB * SEQ, NMETA = 16, M1 = NREAL + NMETA;
constexpr int LP = 4160;
constexpr int NH = 8, DQK = 192, DNOPE = 128, DROPE = 64, DV = 128, QLR = 384, KVLR = 256;
constexpr int NE = 32, DE = 256;
constexpr int NSLOT = 2 * M1;
constexpr float EPS = 1e-6f;
constexpr float ATTN_SCALE = 0.07216878364870322f;
constexpr int NTHR = 512;
constexpr int LDS_BYTES = 163840;
constexpr int LDS_XB = LDS_BYTES - 16;
constexpr int NPHASE = 11;

constexpr size_t al256(size_t x) { return (x + 255) & ~(size_t)255; }
constexpr size_t WS_CTL = 0;
constexpr size_t CTL_BYTES = 32768;
constexpr size_t CTL_CNT = 16384;
constexpr size_t WS_LISTS = WS_CTL + CTL_BYTES;
constexpr size_t WS_GATEW = al256(WS_LISTS + (size_t)NE * M1 * 4);
constexpr size_t WS_RSTD = al256(WS_GATEW + (size_t)NSLOT * 4);
constexpr size_t WS_RSTDC = al256(WS_RSTD + (size_t)M1 * 4);
constexpr size_t WS_SSQQ = al256(WS_RSTDC + (size_t)M1 * 4);
constexpr size_t WS_COS = al256(WS_SSQQ + (size_t)NREAL * 8);
constexpr size_t WS_SIN = al256(WS_COS + (size_t)4112 * 32 * 4);
constexpr size_t WS_WR = al256(WS_SIN + (size_t)4112 * 32 * 4);
constexpr size_t WS_BIAS = al256(WS_WR + (size_t)2 * 1024 * 36 * 4);
constexpr size_t WS_WRT = al256(WS_BIAS + 512);
constexpr size_t WS_AWT = al256(WS_WRT + (size_t)2 * 2 * 48 * 1024 * 2);
constexpr size_t WS_WCAT = al256(WS_AWT + (size_t)4 * 256 * 256 * 2);
constexpr size_t WS_WUKV = al256(WS_WCAT + (size_t)768 * 1024 * 2);
constexpr size_t WS_WUQ = al256(WS_WUKV + (size_t)2048 * 256 * 2);
constexpr size_t WS_WO = al256(WS_WUQ + (size_t)1536 * 384 * 2);
constexpr size_t WS_WGU = al256(WS_WO + (size_t)1024 * 1024 * 2);
constexpr size_t WS_WD = al256(WS_WGU + (size_t)NE * 512 * 1024 * 2);
constexpr size_t WS_H = al256(WS_WD + (size_t)NE * 1024 * 256 * 2);
constexpr size_t WS_A = al256(WS_H + (size_t)M1 * D * 4);
constexpr size_t SZ_A = (size_t)NB * LP * 1024 * 2;
constexpr size_t WS_B = al256(WS_A + SZ_A);
constexpr size_t SZ_B = (size_t)NSLOT * 1024 * 2;
constexpr size_t WS_C = al256(WS_B + SZ_B);
constexpr size_t WS_KR = WS_C + (size_t)M1 * 640 * 2;
constexpr size_t SZ_C = (size_t)M1 * 640 * 2 + (size_t)NB * LP * 64 * 2;
constexpr size_t WS_D = al256(WS_C + SZ_C);
constexpr size_t SZ_D = (size_t)NB * LP * 1024 * 2;
constexpr size_t WS_END = WS_D + SZ_D;
static_assert((size_t)NREAL * 1536 * 2 <= SZ_B, "Q fits in region B");
static_assert((size_t)(NSLOT + 128) * 256 * 2 <= SZ_D, "ACT fits in region D");
static_assert((size_t)M1 * 1024 * 2 <= SZ_A, "HB fits in region A");

struct Args {
    const float* x; const float* meta; const float* a_norm; const float* a_w; const float* a_scale;
    const float* b_norm; const float* w_dq; const float* q_norm; const float* w_uq; const float* w_o;
    const float* kv_norm; const float* w_dkv; const float* kv_lat_norm; const float* w_uk; const float* w_uv;
    const float* ffn_norm; const float* router_g; const float* router_g_bias; const float* router_e; const float* router_e_bias;
    const float* w_gate; const float* w_up; const float* w_down; const float* final_norm;
    float* out; unsigned char* ws; int ph_lo, ph_hi;
};

DEV unsigned pk2(float lo, float hi) {
    typedef __bf16 b2 __attribute__((ext_vector_type(2)));
    f32x2 v = {lo, hi}; b2 b = __builtin_convertvector(v, b2); return __builtin_bit_cast(unsigned, b);
}
DEV float bf2f(unsigned short u) { return __uint_as_float((unsigned)u << 16); }
DEV float bflo(unsigned u) { return __uint_as_float(u << 16); }
DEV float bfhi(unsigned u) { return __uint_as_float(u & 0xffff0000u); }
DEV int otid() { int t = threadIdx.x; asm volatile("" : "+v"(t)); return t; }
DEV float wave_sum(float v) {
#pragma unroll
    for (int o = 32; o >= 1; o >>= 1) v += __shfl_xor(v, o);
    return v;
}
DEV const float* h0_row(const Args& a, int t) { return t < NREAL ? a.x + (size_t)t * D : a.meta + (size_t)(t - NREAL) * D; }
DEV const float* seq_row(const Args& a, int b, int p) { return p < NMETA ? a.meta + (size_t)p * D : a.x + ((size_t)b * SEQ + (p - NMETA)) * D; }

#define XB_TMO      128
#define XB_XCNT(j)  (256  + 64 * (j))
#define XB_XSUB(j)  (1280 + 64 * (j))
#define XB_XGEN(j)  (2304 + 64 * (j))
#define XB_TOP      3328
#define XB_TOPGEN   3392
#define XCD_BAR_WORDS 3456
#define XB_SPIN_CAP (1u << 18)
#define LAS __attribute__((address_space(3)))

__device__ __forceinline__ unsigned xb_ld(unsigned* p)              { return __hip_atomic_load(p, __ATOMIC_RELAXED, __HIP_MEMORY_SCOPE_AGENT); }
__device__ __forceinline__ unsigned xb_add(unsigned* p, unsigned v) { return __hip_atomic_fetch_add(p, v, __ATOMIC_RELAXED, __HIP_MEMORY_SCOPE_AGENT); }
__device__ __forceinline__ unsigned xb_xcc_id() { return (unsigned)__builtin_amdgcn_s_getreg((3 << 11) | 20) & 0xFu; }
#define XB_SPIN(cond, bar) do { unsigned _sp = 0; while (cond) { __builtin_amdgcn_s_sleep(1); \
    if ((++_sp & 255u) == 0u) { if (xb_ld(&(bar)[XB_TMO])) break; if (_sp > XB_SPIN_CAP) { atomicAdd(&(bar)[XB_TMO], 1u); break; } } } } while (0)

struct XcdBarrier { unsigned* bar; unsigned x; volatile LAS unsigned* st; };

__device__ __forceinline__ XcdBarrier xcd_barrier_post(unsigned* bar, volatile LAS unsigned* st) {
    XcdBarrier b; b.bar = bar; b.x = xb_xcc_id(); b.st = st;
    if (threadIdx.x == 0) (void)xb_add(&bar[XB_XCNT(b.x)], 1u);
    return b;
}
__device__ __forceinline__ void xcd_barrier_complete(unsigned* bar, unsigned x, unsigned& nloc, unsigned& nx) {
    const unsigned G = gridDim.x * gridDim.y * gridDim.z;
    unsigned sum, cnt, mine, sp = 0u;
    for (;;) {
        sum = 0u; cnt = 0u; mine = 0u;
#pragma unroll
        for (unsigned j = 0; j < 16; ++j) { const unsigned c = xb_ld(&bar[XB_XCNT(j)]); sum += c; cnt += (c > 0u) ? 1u : 0u; mine = (j == x) ? c : mine; }
        if (sum == G) break;
        __builtin_amdgcn_s_sleep(1);
        if ((++sp & 255u) == 0u) { if (xb_ld(&bar[XB_TMO])) break; if (sp > XB_SPIN_CAP) { atomicAdd(&bar[XB_TMO], 1u); break; } }
    }
    nloc = mine > 0u ? mine : 1u; nx = cnt > 0u ? cnt : 1u;
}
__device__ __forceinline__ void xcd_barrier(const XcdBarrier& b) {
    asm volatile("s_waitcnt vmcnt(0)" ::: "memory");
    __syncthreads();
    if (threadIdx.x == 0) {
        unsigned* bar = b.bar;
        __builtin_amdgcn_s_waitcnt(0);
        unsigned nloc = b.st[0], nx = b.st[1];
        if (nloc == 0u) { xcd_barrier_complete(bar, b.x, nloc, nx); b.st[0] = nloc; b.st[1] = nx; }
        const unsigned old = xb_add(&bar[XB_XSUB(b.x)], 1u);
        const unsigned gen = old / nloc;
        if (old + 1u == (gen + 1u) * nloc) {
            __builtin_amdgcn_fence(__ATOMIC_RELEASE, "agent");
            asm volatile("s_waitcnt vmcnt(0)" ::: "memory");
            const unsigned og = xb_add(&bar[XB_TOP], 1u);
            const unsigned tg = og / nx;
            if (og + 1u == (tg + 1u) * nx) xb_add(&bar[XB_TOPGEN], 1u);
            else XB_SPIN(xb_ld(&bar[XB_TOPGEN]) == tg, bar);
            __builtin_amdgcn_fence(__ATOMIC_ACQUIRE, "agent");
            xb_add(&bar[XB_XGEN(b.x)], 1u);
            asm volatile("s_waitcnt vmcnt(0)" ::: "memory");
        } else {
            XB_SPIN(xb_ld(&bar[XB_XGEN(b.x)]) == gen, bar);
            __builtin_amdgcn_fence(__ATOMIC_ACQUIRE, "agent");
            asm volatile("s_waitcnt vmcnt(0)" ::: "memory");
        }
    }
    __syncthreads();
}

constexpr int G_STAGE = 49152;
constexpr int G_LDS = 3 * G_STAGE;
template <int I, class AR, class BR, class KO>
DEV void naive_steps(f32x4 (&acc)[4][4], int nk, int mcnt, int wr, int wc, int fr, int fq, AR arow, BR brow, KO koff) {
    if constexpr (I < 64) {
        constexpr int m = I >> 4, n = (I >> 2) & 3, j = I & 3;
        if (m < mcnt) {
            const bf16_t* ap = arow(wr * 64 + m * 16 + fr);
            const bf16_t* bp = brow(wc * 64 + n * 16 + fq * 4 + j);
            float s = 0.f;
#pragma unroll 1
            for (int kc = 0; kc < nk; ++kc) {
                const u32x4* pa = (const u32x4*)(ap + koff(kc));
                const u32x4* pb = (const u32x4*)(bp + kc * 64);
#pragma unroll 2
                for (int c = 0; c < 8; ++c) {
                    const u32x4 va = pa[c], vb = pb[c];
#pragma unroll
                    for (int e = 0; e < 4; ++e) { s = fmaf(bflo(va[e]), bflo(vb[e]), s); s = fmaf(bfhi(va[e]), bfhi(vb[e]), s); }
                }
            }
            acc[m][n][j] += s;
        }
        naive_steps<I + 1>(acc, nk, mcnt, wr, wc, fr, fq, arow, brow, koff);
    }
}
struct GtPtrs { const bf16_t* pa0; const bf16_t* pa1; const bf16_t* pb0; const bf16_t* pb1; const bf16_t* pb2; const bf16_t* pb3; };
template <class AR, class BR>
DEV GtPtrs gt_ptrs(AR arow, BR brow) {
    const int tid = otid(), srow = tid >> 3, sx = ((tid & 7) ^ (srow & 7)) * 8;
    GtPtrs P; P.pa0 = arow(srow) + sx; P.pa1 = arow(srow + 64) + sx;
    P.pb0 = brow(srow) + sx; P.pb1 = brow(srow + 64) + sx; P.pb2 = brow(srow + 128) + sx; P.pb3 = brow(srow + 192) + sx;
    return P;
}
#define GLDS16(g, l) __builtin_amdgcn_global_load_lds((const unsigned*)(g), (unsigned*)(l), 16, 0, 0)
#define STAGE_T(so, kc) do { char* base_ = lds + (so) + threadIdx.x * 16; const int ka_ = koff(kc), kb_ = (kc) * 64; \
        GLDS16(P.pa0 + ka_, base_); GLDS16(P.pa1 + ka_, base_ + 8192); \
        GLDS16(P.pb0 + kb_, base_ + 16384); GLDS16(P.pb1 + kb_, base_ + 24576); GLDS16(P.pb2 + kb_, base_ + 32768); GLDS16(P.pb3 + kb_, base_ + 40960); } while (0)
template <class KO>
DEV void gt_issue2(char* lds, const GtPtrs& P, int nk, KO koff) {
    asm volatile("" ::: "memory");
    STAGE_T(0, 0);
    if (nk > 1) STAGE_T(G_STAGE, 1);
    asm volatile("" ::: "memory");
}
#define WAITV(n) asm volatile("s_waitcnt vmcnt(%0)" :: "i"(n) : "memory")
template <int NEPI, int MODE = 0, class KO>
DEV void gt_run(char* lds, f32x4 (&acc)[4][4], int nk, const GtPtrs& P, KO koff, bool pre, int nvalid = 128) {
    const int tid = threadIdx.x, lane = tid & 63, wid = tid >> 6, wr = wid >> 2, wc = wid & 3, fr = lane & 15, fq = lane >> 4;
    const int offk0 = ((fq ^ (fr & 7)) << 4), offk1 = (((4 + fq) ^ (fr & 7)) << 4);
    const int aoff = (wr * 64 + fr) * 128, boff = 16384 + (wc * 64 + fr) * 128;
    const int wru = __builtin_amdgcn_readfirstlane(wr);
    int mcnt = (nvalid - wru * 64 + 15) >> 4; mcnt = mcnt < 0 ? 0 : (mcnt > 4 ? 4 : mcnt);
#define GBAR() do { __builtin_amdgcn_sched_barrier(0); __builtin_amdgcn_s_barrier(); __builtin_amdgcn_sched_barrier(0); } while (0)
    if (NEPI > 0 && pre) { if (nk > 1) WAITV(6 + NEPI); else WAITV(NEPI); }
    else { if (nk > 1) WAITV(6); else WAITV(0); }
    GBAR();
    if (wru == 1) GBAR();
    int so = 0, so2 = 2 * G_STAGE;
#pragma unroll 1
    for (int t = 0; t < nk; ++t) {
        if (MODE != 2) { if (t + 2 < nk) STAGE_T(so2, t + 2); }
        const char* As = lds + so + aoff; const char* Bs = lds + so + boff;
        bf16x8 bq[4][2], aq[4][2];
        if (MODE != 3 || mcnt > 0) {
#pragma unroll
        for (int n = 0; n < 4; ++n) { bq[n][0] = *(const bf16x8*)(Bs + n * 2048 + offk0); bq[n][1] = *(const bf16x8*)(Bs + n * 2048 + offk1); }
#pragma unroll
        for (int m = 0; m < 4; ++m) { if (MODE != 3 || m == 0) { aq[m][0] = *(const bf16x8*)(As + m * 2048 + offk0); aq[m][1] = *(const bf16x8*)(As + m * 2048 + offk1); } }
        }
        if (NEPI > 0 && pre && t == 0) { if (t + 2 < nk) WAITV(6 + NEPI); else WAITV(NEPI); }
        else { if (t + 2 < nk) WAITV(6); else WAITV(0); }
        asm volatile("s_waitcnt lgkmcnt(0)" ::: "memory");
        GBAR();
        if (MODE == 1) {
#pragma unroll
            for (int m = 0; m < 4; ++m) { asm volatile("" :: "v"(aq[m][0]), "v"(aq[m][1]), "v"(bq[m][0]), "v"(bq[m][1])); }
        } else if (MODE == 3) {
            if (mcnt > 0) {
#pragma unroll
                for (int n = 0; n < 4; ++n) {
                    acc[0][n] = __builtin_amdgcn_mfma_f32_16x16x32_bf16(bq[n][0], aq[0][0], acc[0][n], 0, 0, 0);
                    acc[0][n] = __builtin_amdgcn_mfma_f32_16x16x32_bf16(bq[n][1], aq[0][1], acc[0][n], 0, 0, 0);
                }
            }
        } else {
        __builtin_amdgcn_s_setprio(1);
#pragma unroll
        for (int m = 0; m < 4; ++m)
#pragma unroll
            for (int n = 0; n < 4; ++n) {
                acc[m][n] = __builtin_amdgcn_mfma_f32_16x16x32_bf16(bq[n][0], aq[m][0], acc[m][n], 0, 0, 0);
                acc[m][n] = __builtin_amdgcn_mfma_f32_16x16x32_bf16(bq[n][1], aq[m][1], acc[m][n], 0, 0, 0);
            }
        __builtin_amdgcn_s_setprio(0);
        }
        GBAR();
        so2 = so; so = so + G_STAGE; if (so == 3 * G_STAGE) so = 0;
    }
    if (wru == 0) GBAR();
#undef GBAR
}
struct GtStream { int so; int wru; };
#define STAGE_PX(PP, KOFF, so_, kc) do { char* base_ = lds + (so_) + threadIdx.x * 16; const int ka_ = KOFF(kc), kb_ = (kc) * 64; \
        GLDS16((PP).pa0 + ka_, base_); GLDS16((PP).pa1 + ka_, base_ + 8192); \
        GLDS16((PP).pb0 + kb_, base_ + 16384); GLDS16((PP).pb1 + kb_, base_ + 24576); GLDS16((PP).pb2 + kb_, base_ + 32768); GLDS16((PP).pb3 + kb_, base_ + 40960); } while (0)
#define SBAR_() do { __builtin_amdgcn_sched_barrier(0); __builtin_amdgcn_s_barrier(); __builtin_amdgcn_sched_barrier(0); } while (0)
template <class KO>
DEV void gt_stream_begin(char* lds, GtStream& S, const GtPtrs& P, KO koff) {
    S.so = 0; S.wru = __builtin_amdgcn_readfirstlane((int)(threadIdx.x >> 8));
    asm volatile("" ::: "memory");
    STAGE_PX(P, koff, 0, 0); STAGE_PX(P, koff, G_STAGE, 1);
    asm volatile("" ::: "memory");
    WAITV(6);
    SBAR_();
    if (S.wru == 1) SBAR_();
}
template <int NEPI, class KO, class KON, class PNF>
DEV void gt_stream_tile(char* lds, GtStream& S, f32x4 (&acc)[4][4], int nk, const GtPtrs& P, KO koff, bool pre, bool has_next, PNF next_ptrs, KON koffn) {
    const int tid = threadIdx.x, lane = tid & 63, wid = tid >> 6, wr = wid >> 2, wc = wid & 3, fr = lane & 15, fq = lane >> 4;
    const int offk0 = ((fq ^ (fr & 7)) << 4), offk1 = (((4 + fq) ^ (fr & 7)) << 4);
    const int aoff = (wr * 64 + fr) * 128, boff = 16384 + (wc * 64 + fr) * 128;
    asm volatile("" ::: "memory");
    int so = S.so;
    GtPtrs Pn;
#pragma unroll 1
    for (int t = 0; t < nk; ++t) {
        int so2 = so + 2 * G_STAGE; if (so2 >= 3 * G_STAGE) so2 -= 3 * G_STAGE;
        const bool own = t + 2 < nk, nxt = !own && has_next;
        if (nxt && t + 2 == nk) Pn = next_ptrs();
        if (own) STAGE_PX(P, koff, so2, t + 2);
        else if (nxt) STAGE_PX(Pn, koffn, so2, t + 2 - nk);
        const char* As = lds + so + aoff; const char* Bs = lds + so + boff;
        bf16x8 bq[4][2], aq[4][2];
#pragma unroll
        for (int n = 0; n < 4; ++n) { bq[n][0] = *(const bf16x8*)(Bs + n * 2048 + offk0); bq[n][1] = *(const bf16x8*)(Bs + n * 2048 + offk1); }
#pragma unroll
        for (int m = 0; m < 4; ++m) { aq[m][0] = *(const bf16x8*)(As + m * 2048 + offk0); aq[m][1] = *(const bf16x8*)(As + m * 2048 + offk1); }
        if (t + 1 < nk || has_next) {
            if (NEPI > 0 && pre && t == 0) { if (own || nxt) WAITV(6 + NEPI); else WAITV(NEPI); }
            else { if (own || nxt) WAITV(6); else WAITV(0); }
        }
        asm volatile("s_waitcnt lgkmcnt(0)" ::: "memory");
        SBAR_();
        __builtin_amdgcn_s_setprio(1);
#pragma unroll
        for (int m = 0; m < 4; ++m)
#pragma unroll
            for (int n = 0; n < 4; ++n) {
                acc[m][n] = __builtin_amdgcn_mfma_f32_16x16x32_bf16(bq[n][0], aq[m][0], acc[m][n], 0, 0, 0);
                acc[m][n] = __builtin_amdgcn_mfma_f32_16x16x32_bf16(bq[n][1], aq[m][1], acc[m][n], 0, 0, 0);
            }
        __builtin_amdgcn_s_setprio(0);
        SBAR_();
        so += G_STAGE; if (so == 3 * G_STAGE) so = 0;
    }
    S.so = so;
    asm volatile("" ::: "memory");
}
DEV void gt_stream_end(GtStream& S) { if (S.wru == 0) SBAR_(); }
template <int MODE = 0, class AR, class BR, class KO>
DEV void gemm_tile(char* lds, f32x4 (&acc)[4][4], int nk, int nvalid, AR arow, BR brow, KO koff) {
    (void)nvalid;
#if NAIVE_GEMM
    const int tid = threadIdx.x, lane = tid & 63, wid = tid >> 6, wr = wid >> 2, wc = wid & 3, fr = lane & 15, fq = lane >> 4;
    naive_steps<0>(acc, nk, 4, wr, wc, fr, fq, arow, brow, koff);
#else
    const GtPtrs P = gt_ptrs(arow, brow);
    gt_issue2(lds, P, nk, koff);
    gt_run<0, MODE>(lds, acc, nk, P, koff, false);
#endif
}
DEV int pcol(int c) { return (c & 0xC3) | (((c >> 2) & 3) << 4) | (((c >> 4) & 3) << 2); }
DEV int rcol(int c) { const int n = (c >> 4) & 3, q = (c >> 2) & 3, e = c & 3; return (c & 0xC0) | ((n >> 1) << 5) | (q << 3) | ((n & 1) << 2) | e; }
DEV u32x4 pk8(f32x4 x, f32x4 y) { return u32x4{pk2(x[0], x[1]), pk2(x[2], x[3]), pk2(y[0], y[1]), pk2(y[2], y[3])}; }
DEV void zero_acc(f32x4 (&acc)[4][4]) {
#pragma unroll
    for (int m = 0; m < 4; ++m)
#pragma unroll
        for (int n = 0; n < 4; ++n) acc[m][n] = f32x4{0.f, 0.f, 0.f, 0.f};
}
DEV float tile_row_reduce(char* lds_red, const float (&ssq)[4]) {
    const int tid = otid(), lane = tid & 63, wid = tid >> 6, wr = wid >> 2, wc = wid & 3, fr = lane & 15, fq = lane >> 4;
    float* red = (float*)lds_red;
#pragma unroll
    for (int m = 0; m < 4; ++m) {
        float v = ssq[m]; v += __shfl_xor(v, 16); v += __shfl_xor(v, 32);
        if (fq == 0) red[(wr * 64 + m * 16 + fr) * 4 + wc] = v;
    }
    asm volatile("s_waitcnt lgkmcnt(0)" ::: "memory"); __builtin_amdgcn_s_barrier(); asm volatile("" ::: "memory");
    float r = 0.f;
    if (tid < 128) r = (red[tid * 4 + 0] + red[tid * 4 + 1]) + (red[tid * 4 + 2] + red[tid * 4 + 3]);
    asm volatile("s_waitcnt lgkmcnt(0)" ::: "memory"); __builtin_amdgcn_s_barrier(); asm volatile("" ::: "memory");
    return r;
}
constexpr int LDS_RED = G_LDS;
constexpr int LDS_TAB = G_LDS + 2048;

DEV int rowmap(int mode, int n) { return mode == 0 ? n : ((n >> 7) * 256 + ((n & 127) >> 5) * 64 + (n & 31) + (mode == 2 ? 32 : 0)); }
DEV void tr_tile(char* lds, const float* __restrict__ src, int ld, int k0, int n0, int nb, bf16_t* __restrict__ dst, int ldd, const float* sk, const float* sn, int mode) {
    const int tid = otid(), nl = tid & 63, kg = tid >> 6;
    float v[4][8];
#pragma unroll
    for (int j = 0; j < 4; ++j)
        if (j < nb) {
#pragma unroll
            for (int i = 0; i < 8; ++i) v[j][i] = src[(size_t)(k0 + kg * 8 + i) * ld + n0 + j * 64 + nl];
        }
    float skv[8];
#pragma unroll
    for (int i = 0; i < 8; ++i) skv[i] = sk ? sk[k0 + kg * 8 + i] : 1.f;
#pragma unroll
    for (int j = 0; j < 4; ++j)
        if (j < nb) {
            const float snv = sn ? sn[n0 + j * 64 + nl] : 1.f;
            const u32x4 w = {pk2(v[j][0] * skv[0] * snv, v[j][1] * skv[1] * snv), pk2(v[j][2] * skv[2] * snv, v[j][3] * skv[3] * snv),
                             pk2(v[j][4] * skv[4] * snv, v[j][5] * skv[5] * snv), pk2(v[j][6] * skv[6] * snv, v[j][7] * skv[7] * snv)};
            *(u32x4*)(lds + j * 9216 + nl * 144 + kg * 16) = w;
        }
    __syncthreads();
    const int r = tid >> 3, c = tid & 7;
#pragma unroll
    for (int j = 0; j < 4; ++j)
        if (j < nb) {
            const u32x4 o = *(const u32x4*)(lds + j * 9216 + r * 144 + c * 16);
            *(u32x4*)(dst + (size_t)rowmap(mode, n0 + j * 64 + r) * ldd + k0 + c * 8) = o;
        }
    __syncthreads();
}
constexpr int TR_SMALL = 212, TR_MOE = 1536;
DEV void tr_small_job(char* lds, const Args& a, int i) {
    unsigned char* ws = a.ws;
    if (i < 16) { const int g = i >> 2, kt = i & 3;
        tr_tile(lds, a.a_w + (size_t)g * 65536, 256, kt * 64, 0, 4, (bf16_t*)(ws + WS_AWT) + (size_t)g * 65536, 256, a.a_norm + g * 256, a.a_scale + g * 256, 0); return; }
    i -= 16;
    if (i < 32) { const int kt = i >> 1, h = i & 1;
        tr_tile(lds, a.w_dkv, 320, kt * 64, h * 256, h ? 1 : 4, (bf16_t*)(ws + WS_WCAT), 1024, a.kv_norm, nullptr, 0); return; }
    i -= 32;
    if (i < 32) { const int kt = i >> 1, h = i & 1;
        tr_tile(lds, a.w_dq, 384, kt * 64, h * 256, h ? 2 : 4, (bf16_t*)(ws + WS_WCAT) + (size_t)320 * 1024, 1024, a.b_norm, nullptr, 0); return; }
    i -= 32;
    if (i < 16) { const int kt = i >> 2, ng = i & 3;
        tr_tile(lds, a.w_uk, 1024, kt * 64, ng * 256, 4, (bf16_t*)(ws + WS_WUKV), 256, a.kv_lat_norm, nullptr, 0); return; }
    i -= 16;
    if (i < 16) { const int kt = i >> 2, ng = i & 3;
        tr_tile(lds, a.w_uv, 1024, kt * 64, ng * 256, 4, (bf16_t*)(ws + WS_WUKV) + (size_t)1024 * 256, 256, a.kv_lat_norm, nullptr, 0); return; }
    i -= 16;
    if (i < 36) { const int kt = i / 6, ng = i % 6;
        tr_tile(lds, a.w_uq, 1536, kt * 64, ng * 256, 4, (bf16_t*)(ws + WS_WUQ), 384, a.q_norm, nullptr, 0); return; }
    i -= 36;
    { const int kt = i >> 2, ng = i & 3;
        tr_tile(lds, a.w_o, 1024, kt * 64, ng * 256, 4, (bf16_t*)(ws + WS_WO), 1024, nullptr, nullptr, 0); }
}
DEV void tr_moe_job(char* lds, const Args& a, int l, int i) {
    unsigned char* ws = a.ws;
    const int e = i / 48, r = i % 48;
    const size_t eo = (size_t)(l * NE + e) * 262144;
    if (r < 32) { const int up = r >> 4, kt = r & 15;
        tr_tile(lds, (up ? a.w_up : a.w_gate) + eo, 256, kt * 64, 0, 4, (bf16_t*)(ws + WS_WGU) + (size_t)e * 524288, 1024, a.ffn_norm + l * 1024, nullptr, up ? 2 : 1); }
    else { const int rr = r - 32, kt = rr >> 2, ng = rr & 3;
        tr_tile(lds, a.w_down + eo, 1024, kt * 64, ng * 256, 4, (bf16_t*)(ws + WS_WD) + (size_t)e * 262144, 256, nullptr, nullptr, 0); }
}
DEV void phase_prologue(char* lds, const Args& a) {
    const int G = gridDim.x, bid = blockIdx.x, tid = threadIdx.x;
    unsigned char* ws = a.ws;
    const int gt = bid * NTHR + tid, GT = G * NTHR;
    bf16_t* WRT = (bf16_t*)(ws + WS_WRT);
    for (int i = gt; i < 2 * 48 * 1024; i += GT) { const int l = i / 49152, r = i % 49152, o = r >> 10, k = r & 1023;
        float w = 0.f;
        if (o < 36) w = (o < 4 ? a.router_g[(size_t)(l * 1024 + k) * 4 + o] : a.router_e[(size_t)(l * 1024 + k) * 32 + (o - 4)]) * a.ffn_norm[l * 1024 + k];
        const unsigned hi = pk2(w, 0.f) & 0xffffu; const float lo = w - __uint_as_float(hi << 16);
        WRT[(size_t)l * 98304 + r] = (bf16_t)hi; WRT[(size_t)l * 98304 + 49152 + r] = (bf16_t)(pk2(lo, 0.f) & 0xffffu); }
    float* BI = (float*)(ws + WS_BIAS);
    for (int i = gt; i < 128; i += GT) { const int l = i >> 6, o = i & 63; BI[i] = o < 4 ? a.router_g_bias[l * 4 + o] : (o < 36 ? a.router_e_bias[l * 32 + o - 4] : 0.f); }
    float* COS = (float*)(ws + WS_COS); float* SIN = (float*)(ws + WS_SIN);
    for (int i = gt; i < 4112 * 32; i += GT) { const int p = i >> 5, f = i & 31;
        const double inv = pow(10000.0, -(double)f / 32.0), ang = (double)p * inv; COS[i] = (float)cos(ang); SIN[i] = (float)sin(ang); }
    u32x4* wz = (u32x4*)((bf16_t*)(ws + WS_WCAT) + (size_t)704 * 1024);
    for (int i = gt; i < 64 * 1024 / 8; i += GT) wz[i] = u32x4{0u, 0u, 0u, 0u};
    for (int i = bid; i < TR_SMALL; i += G) tr_small_job(lds, a, i);
}

template <int W>
DEV void pool_cols(char* lds, const Args& a, int b, int pstart, int nrows, int first_out, bf16_t* __restrict__ po_base  , int c0) {
    const int tid = otid(), lane = tid & 63, wid = tid >> 6;
    float* part = (float*)lds;
    float* rsb = (float*)(lds + 512);
    f32x2 ring[16]; f32x2 sum = {0.f, 0.f};
#pragma unroll
    for (int j = 0; j < 16; ++j) ring[j] = f32x2{0.f, 0.f};
    f32x2 ldn[16];
#pragma unroll
    for (int j = 0; j < 16; ++j) { const int ii = j < nrows ? j : nrows - 1; ldn[j] = *(const f32x2*)(seq_row(a, b, pstart + ii) + c0); }
#pragma unroll 1
    for (int ib = 0; ib < nrows; ib += 16) {
        f32x2 ld[16];
#pragma unroll
        for (int j = 0; j < 16; ++j) ld[j] = ldn[j];
        if (ib + 16 < nrows) {
#pragma unroll
            for (int j = 0; j < 16; ++j) { const int i = ib + 16 + j; const int ii = i < nrows ? i : nrows - 1;
                ldn[j] = *(const f32x2*)(seq_row(a, b, pstart + ii) + c0); }
        }
#pragma unroll
        for (int j = 0; j < 16; ++j) { const float p = wave_sum(ld[j][0] * ld[j][0] + ld[j][1] * ld[j][1]); if (lane == 0) part[wid * 16 + j] = p; }
        asm volatile("s_waitcnt lgkmcnt(0)" ::: "memory"); __builtin_amdgcn_s_barrier(); asm volatile("" ::: "memory");
        if (tid < 16) { const float sq = ((part[tid] + part[16 + tid]) + (part[32 + tid] + part[48 + tid])) + ((part[64 + tid] + part[80 + tid]) + (part[96 + tid] + part[112 + tid]));
            rsb[tid] = rsqrtf(sq * (1.f / D) + EPS); }
        asm volatile("s_waitcnt lgkmcnt(0)" ::: "memory"); __builtin_amdgcn_s_barrier(); asm volatile("" ::: "memory");
#pragma unroll
        for (int j = 0; j < 16; ++j) { const int i = ib + j;
            if (i < nrows) {
                const float r = rsb[j]; const f32x2 v = {ld[j][0] * r, ld[j][1] * r};
                const f32x2 old = ring[(j - W) & 15];
                sum[0] += v[0] - old[0]; sum[1] += v[1] - old[1];
                ring[j] = v;
                if (i >= first_out) { const int pos = pstart + i; const float ic = 1.f / (float)(pos + 1 < W ? pos + 1 : W);
                    *(unsigned*)(po_base + (size_t)(i - first_out) * D + c0) = pk2(sum[0] * ic - v[0], sum[1] * ic - v[1]); }
            }
        }
    }
}
DEV void pool_unit(char* lds, const Args& a, int u) {
    const int tid = otid(), wid = tid >> 6;
    bf16_t* PO = (bf16_t*)(a.ws + WS_B);
    int b, pstart, nrows, first_out, t0;
    if (u < 256) { b = u >> 5; const int s0 = (u & 31) * 128; pstart = s0 + 1; nrows = 143; first_out = 15; t0 = u * 128; }
    else { b = 0; pstart = 0; nrows = 16; first_out = 0; t0 = NREAL; }
    __syncthreads();
    const int c0 = tid * 2, g = __builtin_amdgcn_readfirstlane(wid >> 1);
    bf16_t* pob = PO + (size_t)t0 * D;
    if (g == 0) pool_cols<2>(lds, a, b, pstart, nrows, first_out, pob, c0);
    else if (g == 1) pool_cols<4>(lds, a, b, pstart, nrows, first_out, pob, c0);
    else if (g == 2) pool_cols<8>(lds, a, b, pstart, nrows, first_out, pob, c0);
    else pool_cols<16>(lds, a, b, pstart, nrows, first_out, pob, c0);
    __syncthreads();
}

constexpr int R_PART = 0;
constexpr int R_HIST = 98304, R_ENT = R_HIST + 256;
DEV void router_acc(f32x4 (&racc)[4][3], const f32x4 (&hh)[4][4], const bf16_t* WH, const bf16_t* WL, int colbase, int fr, int fq) {
#pragma unroll
    for (int kk = 0; kk < 2; ++kk) {
        bf16x8 bh[3], bl[3];
#pragma unroll
        for (int n = 0; n < 3; ++n) { const size_t o = (size_t)(n * 16 + fr) * 1024 + colbase + fq * 16 + kk * 8; bh[n] = *(const bf16x8*)(WH + o); bl[n] = *(const bf16x8*)(WL + o); }
#pragma unroll
        for (int m = 0; m < 4; ++m) {
            const f32x4 v0 = hh[m][2 * kk], v1 = hh[m][2 * kk + 1];
            const unsigned h0 = pk2(v0[0], v0[1]), h1 = pk2(v0[2], v0[3]), h2 = pk2(v1[0], v1[1]), h3 = pk2(v1[2], v1[3]);
            const u32x4 hv = {h0, h1, h2, h3};
            const u32x4 lv = {pk2(v0[0] - bflo(h0), v0[1] - bfhi(h0)), pk2(v0[2] - bflo(h1), v0[3] - bfhi(h1)), pk2(v1[0] - bflo(h2), v1[1] - bfhi(h2)), pk2(v1[2] - bflo(h3), v1[3] - bfhi(h3))};
            const bf16x8 ah = __builtin_bit_cast(bf16x8, hv), al = __builtin_bit_cast(bf16x8, lv);
#pragma unroll
            for (int n = 0; n < 3; ++n) {
                racc[m][n] = __builtin_amdgcn_mfma_f32_16x16x32_bf16(ah, bh[n], racc[m][n], 0, 0, 0);
                racc[m][n] = __builtin_amdgcn_mfma_f32_16x16x32_bf16(al, bh[n], racc[m][n], 0, 0, 0);
                racc[m][n] = __builtin_amdgcn_mfma_f32_16x16x32_bf16(ah, bl[n], racc[m][n], 0, 0, 0);
            }
        }
    }
}
DEV void router_part_store(char* lds, const f32x4 (&racc)[4][3], int wr, int wc, int fr, int fq) {
    float* part = (float*)(lds + R_PART);
#pragma unroll
    for (int m = 0; m < 4; ++m)
#pragma unroll
        for (int n = 0; n < 3; ++n)
#pragma unroll
            for (int e = 0; e < 4; ++e) part[(wc * 128 + wr * 64 + m * 16 + fq * 4 + e) * 48 + n * 16 + fr] = racc[m][n][e];
}
DEV void mixer_unit(char* lds, const Args& a, int u) {
    const int tid = otid(), lane = tid & 63, wid = tid >> 6, wr = wid >> 2, wc = wid & 3, fr = lane & 15, fq = lane >> 4;
    const bf16_t* PO = (const bf16_t*)(a.ws + WS_B);
    const bf16_t* AWT = (const bf16_t*)(a.ws + WS_AWT);
    float* H = (float*)(a.ws + WS_H); bf16_t* HB = (bf16_t*)(a.ws + WS_A); float* RSTD = (float*)(a.ws + WS_RSTD);
    {
        const int t0 = u * 128, nvalid = u < 256 ? 128 : 16;
        float ssq[4] = {0.f, 0.f, 0.f, 0.f};
        f32x4 racc[4][3];
#pragma unroll
        for (int m = 0; m < 4; ++m)
#pragma unroll
            for (int n = 0; n < 3; ++n) racc[m][n] = f32x4{0.f, 0.f, 0.f, 0.f};
        const bf16_t* WH = (const bf16_t*)(a.ws + WS_WRT); const bf16_t* WL = WH + 49152;
        auto koff = [](int kc) { return kc * 64; };
        const bool full = nvalid == 128;
        { const GtPtrs P0 = gt_ptrs([&](int r) { return PO + (size_t)(t0 + (r < nvalid ? r : 0)) * D; }, [&](int c) { return AWT + (size_t)pcol(c) * 256; });
          gt_issue2(lds, P0, 4, koff); }
        bool pre = false;
#pragma unroll 1
        for (int g = 0; g < 4; ++g) {
            f32x4 acc[4][4]; zero_acc(acc);
            const GtPtrs P = gt_ptrs([&](int r) { return PO + (size_t)(t0 + (r < nvalid ? r : 0)) * D + g * 256; }, [&](int c) { return AWT + (size_t)g * 65536 + (size_t)pcol(c) * 256; });
            if (full) gt_run<16>(lds, acc, 4, P, koff, pre); else gt_run<0, 3>(lds, acc, 4, P, koff, false, nvalid);
            const int tid = otid(), lane = tid & 63, wid = tid >> 6, wr = wid >> 2, wc = wid & 3, fr = lane & 15, fq = lane >> 4;
            f32x4 hh[4][4];
#pragma unroll
            for (int m = 0; m < 4; ++m) { const int r = wr * 64 + m * 16 + fr; const float* hr = h0_row(a, t0 + (r < nvalid ? r : 0)) + g * 256 + wc * 64 + fq * 16;
#pragma unroll
                for (int n = 0; n < 4; ++n) hh[m][n] = *(const f32x4*)(hr + n * 4); }
#pragma unroll
            for (int m = 0; m < 4; ++m)
#pragma unroll
                for (int n = 0; n < 4; ++n) hh[m][n] += acc[m][n];
            router_acc(racc, hh, WH, WL, g * 256 + wc * 64, fr, fq);
#pragma unroll
            for (int m = 0; m < 4; ++m)
#pragma unroll
                for (int n = 0; n < 3; ++n) asm volatile("" : "+v"(racc[m][n]));
            if (g < 3) { const int g1 = g + 1;
                const GtPtrs Pn = gt_ptrs([&](int r) { return PO + (size_t)(t0 + (r < nvalid ? r : 0)) * D + g1 * 256; }, [&](int c) { return AWT + (size_t)g1 * 65536 + (size_t)pcol(c) * 256; });
                gt_issue2(lds, Pn, 4, koff); }
            pre = full;
#pragma unroll
            for (int m = 0; m < 4; ++m) { const int r = wr * 64 + m * 16 + fr;
                if (r < nvalid) { const int t = t0 + r;
                    const int col0 = g * 256 + wc * 64 + fq * 16;
#pragma unroll
                    for (int n = 0; n < 4; ++n) { const f32x4 h = hh[m][n];
                        *(f32x4*)(H + (size_t)t * D + col0 + n * 4) = h;
                        ssq[m] += h[0] * h[0] + h[1] * h[1] + h[2] * h[2] + h[3] * h[3]; }
                    *(u32x4*)(HB + (size_t)t * D + col0) = pk8(hh[m][0], hh[m][1]); *(u32x4*)(HB + (size_t)t * D + col0 + 8) = pk8(hh[m][2], hh[m][3]); } }
        }
        const float tot = tile_row_reduce(lds + LDS_RED, ssq);
        if (tid < nvalid) RSTD[t0 + tid] = rsqrtf(tot * (1.f / D) + EPS);
        router_part_store(lds, racc, wr, wc, fr, fq);
    }
}

DEV void router_decide(char* lds, const Args& a, int layer, int t0, int nvalid, bool dry) {
    const int tid = otid();
    const float* BI = (const float*)(a.ws + WS_BIAS) + layer * 64;
    const float* RSTD = (const float*)(a.ws + WS_RSTD);
    int* CNT = (int*)(a.ws + WS_CTL + CTL_CNT) + layer * 32; int* LISTS = (int*)(a.ws + WS_LISTS); float* GATEW = (float*)(a.ws + WS_GATEW);
    float* part = (float*)(lds + R_PART);
    int* hist = (int*)(lds + R_HIST); int* base = hist + 32; int* ent_e = (int*)(lds + R_ENT); int* ent_rank = ent_e + 256;
    if (tid < 32) hist[tid] = 0;
    __syncthreads();
    if (tid < nvalid) {
        const int t = t0 + tid; const float rs = RSTD[t];
        const float* p0 = part + tid * 48;
        float g[4];
#pragma unroll
        for (int i = 0; i < 4; ++i) g[i] = ((p0[i] + p0[6144 + i]) + (p0[12288 + i] + p0[18432 + i])) * rs + BI[i];
        int gs = 0; float gm = g[0];
#pragma unroll
        for (int i = 1; i < 4; ++i) if (g[i] > gm) { gm = g[i]; gs = i; }
        float den = 0.f;
#pragma unroll
        for (int i = 0; i < 4; ++i) den += __expf(g[i] - gm);
        const float wg = 1.f / den;
        float m1 = -3.0e38f, m2 = -3.0e38f; int i1 = 0, i2 = 0;
#pragma unroll
        for (int i = 0; i < 8; ++i) { const int o = 4 + gs * 8 + i;
            const float x = ((p0[o] + p0[6144 + o]) + (p0[12288 + o] + p0[18432 + o])) * rs + BI[o];
            if (x > m1) { m2 = m1; i2 = i1; m1 = x; i1 = i; } else if (x > m2) { m2 = x; i2 = i; } }
        const float ex = __expf(m2 - m1), s1 = 1.f / (1.f + ex), s2 = ex * s1;
        const int e1 = gs * 8 + i1, e2 = gs * 8 + i2;
        if (!dry) { GATEW[2 * t] = wg * s1; GATEW[2 * t + 1] = wg * s2; }
        ent_e[2 * tid] = e1; ent_rank[2 * tid] = atomicAdd(&hist[e1], 1);
        ent_e[2 * tid + 1] = e2; ent_rank[2 * tid + 1] = atomicAdd(&hist[e2], 1);
    }
    __syncthreads();
    if (tid < 32) base[tid] = (hist[tid] && !dry) ? atomicAdd(&CNT[tid], hist[tid]) : 0;
    __syncthreads();
    if (tid < 2 * nvalid && !dry) { const int e = ent_e[tid]; LISTS[(size_t)e * M1 + base[e] + ent_rank[tid]] = 2 * (t0 + (tid >> 1)) + (tid & 1); }
    __syncthreads();
}
DEV void router_tile(char* lds, const Args& a, int layer, int t0, int nvalid, bool dry = false) {
    const int tid = otid(), lane = tid & 63, wid = tid >> 6, fr = lane & 15, fq = lane >> 4;
    const bf16_t* WH = (const bf16_t*)(a.ws + WS_WRT) + (size_t)layer * 98304; const bf16_t* WL = WH + 49152;
    const float* BI = (const float*)(a.ws + WS_BIAS) + layer * 64;
    const float* H = (const float*)(a.ws + WS_H); const float* RSTD = (const float*)(a.ws + WS_RSTD);
    int* CNT = (int*)(a.ws + WS_CTL + CTL_CNT) + layer * 32; int* LISTS = (int*)(a.ws + WS_LISTS); float* GATEW = (float*)(a.ws + WS_GATEW);
    float* part = (float*)(lds + R_PART);
    int* hist = (int*)(lds + R_HIST); int* base = hist + 32; int* ent_e = (int*)(lds + R_ENT); int* ent_rank = ent_e + 256;
    if (tid < 32) hist[tid] = 0;
    const int kq = wid & 3, th = wid >> 2;
    f32x4 acc[4][3];
#pragma unroll
    for (int m = 0; m < 4; ++m)
#pragma unroll
        for (int n = 0; n < 3; ++n) acc[m][n] = f32x4{0.f, 0.f, 0.f, 0.f};
    const float* hrow[4];
#pragma unroll
    for (int m = 0; m < 4; ++m) { const int r = th * 64 + m * 16 + fr; hrow[m] = H + (size_t)(t0 + (r < nvalid ? r : 0)) * D + kq * 256 + fq * 8; }
#pragma unroll 2
    for (int s = 0; s < 8; ++s) {
        bf16x8 bh[3], bl[3];
#pragma unroll
        for (int n = 0; n < 3; ++n) { const size_t o = (size_t)(n * 16 + fr) * 1024 + kq * 256 + s * 32 + fq * 8;
            bh[n] = *(const bf16x8*)(WH + o); bl[n] = *(const bf16x8*)(WL + o); }
#pragma unroll
        for (int m = 0; m < 4; ++m) {
            if (__builtin_amdgcn_readfirstlane(th * 64 + m * 16) >= nvalid) continue;
            const f32x4 v0 = *(const f32x4*)(hrow[m] + s * 32), v1 = *(const f32x4*)(hrow[m] + s * 32 + 4);
            unsigned hw[4], lw[4];
#pragma unroll
            for (int e = 0; e < 2; ++e) {
                const unsigned h0 = pk2(v0[2 * e], v0[2 * e + 1]), h1 = pk2(v1[2 * e], v1[2 * e + 1]);
                hw[e] = h0; hw[2 + e] = h1;
                lw[e] = pk2(v0[2 * e] - bflo(h0), v0[2 * e + 1] - bfhi(h0)); lw[2 + e] = pk2(v1[2 * e] - bflo(h1), v1[2 * e + 1] - bfhi(h1));
            }
            const u32x4 hv = {hw[0], hw[1], hw[2], hw[3]}, lv = {lw[0], lw[1], lw[2], lw[3]};
            const bf16x8 ah = __builtin_bit_cast(bf16x8, hv), al = __builtin_bit_cast(bf16x8, lv);
#pragma unroll
            for (int n = 0; n < 3; ++n) {
                acc[m][n] = __builtin_amdgcn_mfma_f32_16x16x32_bf16(ah, bh[n], acc[m][n], 0, 0, 0);
                acc[m][n] = __builtin_amdgcn_mfma_f32_16x16x32_bf16(al, bh[n], acc[m][n], 0, 0, 0);
                acc[m][n] = __builtin_amdgcn_mfma_f32_16x16x32_bf16(ah, bl[n], acc[m][n], 0, 0, 0);
            }
        }
    }
#pragma unroll
    for (int m = 0; m < 4; ++m)
#pragma unroll
        for (int n = 0; n < 3; ++n)
#pragma unroll
            for (int e = 0; e < 4; ++e) part[(kq * 128 + th * 64 + m * 16 + fq * 4 + e) * 48 + n * 16 + fr] = acc[m][n][e];
    router_decide(lds, a, layer, t0, nvalid, dry);
}
DEV void phase_router(char* lds, const Args& a, int layer, int ntok) {
    const int nunits = (ntok + 127) >> 7;
    for (int u = blockIdx.x; u < nunits; u += gridDim.x) { const int t0 = u * 128; router_tile(lds, a, layer, t0, (ntok - t0) < 128 ? (ntok - t0) : 128); }
}

DEV void phase_front(char* lds, const Args& a, bool dry = false) {
    for (int u = blockIdx.x; u < 257; u += gridDim.x) {
        pool_unit(lds, a, u);
        mixer_unit(lds, a, u);
        __syncthreads();
        router_decide(lds, a, 0, u * 128, u < 256 ? 128 : 16, dry);
    }
    if (!dry && blockIdx.x > 0) { __syncthreads(); for (int i = blockIdx.x - 1; i < TR_MOE; i += gridDim.x - 1) tr_moe_job(lds, a, 0, i); }
}
DEV void moe_tables(char* lds, const Args& a, int layer) {
    int* tab = (int*)(lds + LDS_TAB); int* tstart = tab; int* rstart = tab + 33; int* cnt = tab + 66;
    int* CNT = (int*)(a.ws + WS_CTL + CTL_CNT) + layer * 32;
    if (threadIdx.x == 0) { int ts = 0, rsum = 0;
        for (int e = 0; e < 32; ++e) { const int c = __hip_atomic_load(&CNT[e], __ATOMIC_RELAXED, __HIP_MEMORY_SCOPE_AGENT); cnt[e] = c; tstart[e] = ts; rstart[e] = rsum; ts += (c + 127) >> 7; rsum += c; }
        tstart[32] = ts; rstart[32] = rsum; }
    __syncthreads();
}
DEV int vbid() { const int G = gridDim.x, b = blockIdx.x; return (G & 7) ? b : (b & 7) * (G >> 3) + (b >> 3); }
template <class BR>
DEV void gt_ptrs_b(GtPtrs& P, BR brow) {
    const int tid = otid(), srow = tid >> 3, sx = ((tid & 7) ^ (srow & 7)) * 8;
    P.pb0 = brow(srow) + sx; P.pb1 = brow(srow + 64) + sx; P.pb2 = brow(srow + 128) + sx; P.pb3 = brow(srow + 192) + sx;
}
struct MoeItem { int ti, nt0, nt1; };
template <int NTN>
DEV bool moe_item(int T, int k, MoeItem& it) {
    const int G = gridDim.x, v = vbid(), R = T / G, L = T - R * G;
    if (k < R) { it.ti = k * G + v; it.nt0 = 0; it.nt1 = NTN; return true; }
    const int s = v + G * (k - R);
    if (s >= L * NTN) return false;
    it.ti = R * G + s / NTN; it.nt0 = s % NTN; it.nt1 = it.nt0 + 1; return true;
}
DEV void phase_moe1(char* lds, const Args& a, int layer) {
    const int tid = otid(), lane = tid & 63, wid = tid >> 6, wr = wid >> 2, wc = wid & 3, fr = lane & 15, fq = lane >> 4;
    moe_tables(lds, a, layer);
    const int* tab = (const int*)(lds + LDS_TAB); const int* tstart = tab; const int* rstart = tab + 33; const int* cntl = tab + 66;
    const int* LISTS = (const int*)(a.ws + WS_LISTS); const float* RSTD = (const float*)(a.ws + WS_RSTD);
    const bf16_t* HB = (const bf16_t*)(a.ws + WS_A); const bf16_t* WGU = (const bf16_t*)(a.ws + WS_WGU); bf16_t* ACT = (bf16_t*)(a.ws + WS_D);
    auto koff = [](int kc) { return kc * 64; };
    MoeItem it;
    for (int k = 0; moe_item<2>(tstart[32], k, it); ++k) {
        int e = 0;
        while (tstart[e + 1] <= it.ti) ++e;
        const int tile = it.ti - tstart[e], cnt = cntl[e], nvalid = (cnt - tile * 128) < 128 ? (cnt - tile * 128) : 128;
        const int* lst = LISTS + (size_t)e * M1 + tile * 128;
        float rsr[4];
#pragma unroll
        for (int m = 0; m < 4; ++m) { const int r = wr * 64 + m * 16 + fr; rsr[m] = RSTD[lst[r < nvalid ? r : 0] >> 1]; }
#pragma unroll
        for (int m = 0; m < 4; ++m) asm volatile("" : "+v"(rsr[m]));
        GtPtrs P = gt_ptrs([&](int r) { return HB + (size_t)(lst[r < nvalid ? r : 0] >> 1) * D; },
                           [&](int c) { return WGU + (size_t)e * 524288 + (size_t)(it.nt0 * 256 + rcol(c)) * 1024; });
        gt_issue2(lds, P, 16, koff);
        bool pre = false;
#pragma unroll 1
        for (int nt = it.nt0; nt < it.nt1; ++nt) {
            f32x4 acc[4][4]; zero_acc(acc);
            gt_run<4>(lds, acc, 16, P, koff, pre);
            if (nt + 1 < it.nt1) { gt_ptrs_b(P, [&](int c) { return WGU + (size_t)e * 524288 + (size_t)((nt + 1) * 256 + rcol(c)) * 1024; }); gt_issue2(lds, P, 16, koff); }
            pre = nvalid == 128;
#pragma unroll
            for (int m = 0; m < 4; ++m) { const int r = wr * 64 + m * 16 + fr;
                if (r < nvalid) { const float rs = rsr[m];
                    bf16_t* ar = ACT + (size_t)(rstart[e] + tile * 128 + r) * 256 + nt * 128 + wc * 32 + fq * 8;
                    f32x4 o[2];
#pragma unroll
                    for (int n = 0; n < 2; ++n) {
#pragma unroll
                        for (int j = 0; j < 4; ++j) { const float g = acc[m][n][j] * rs, up = acc[m][n + 2][j] * rs; o[n][j] = g / (1.f + __expf(-g)) * up; } }
                    *(u32x4*)ar = pk8(o[0], o[1]); } }
        }
    }
}
DEV void phase_moe2(char* lds, const Args& a, int layer) {
    const int tid = otid(), lane = tid & 63, wid = tid >> 6, wr = wid >> 2, wc = wid & 3, fr = lane & 15, fq = lane >> 4;
    moe_tables(lds, a, layer);
    const int* tab = (const int*)(lds + LDS_TAB); const int* tstart = tab; const int* rstart = tab + 33; const int* cntl = tab + 66;
    const int* LISTS = (const int*)(a.ws + WS_LISTS); const float* GATEW = (const float*)(a.ws + WS_GATEW);
    const bf16_t* ACT = (const bf16_t*)(a.ws + WS_D); const bf16_t* WDT = (const bf16_t*)(a.ws + WS_WD); bf16_t* Y = (bf16_t*)(a.ws + WS_B);
    auto koff = [](int kc) { return kc * 64; };
    MoeItem it;
    for (int k = 0; moe_item<4>(tstart[32], k, it); ++k) {
        int e = 0;
        while (tstart[e + 1] <= it.ti) ++e;
        const int tile = it.ti - tstart[e], cnt = cntl[e], nvalid = (cnt - tile * 128) < 128 ? (cnt - tile * 128) : 128;
        const int* lst = LISTS + (size_t)e * M1 + tile * 128;
        const bf16_t* arows = ACT + (size_t)(rstart[e] + tile * 128) * 256;
        int slot[4]; float gwr[4];
#pragma unroll
        for (int m = 0; m < 4; ++m) { const int r = wr * 64 + m * 16 + fr; slot[m] = lst[r < nvalid ? r : 0]; gwr[m] = GATEW[slot[m]]; }
#pragma unroll
        for (int m = 0; m < 4; ++m) asm volatile("" : "+v"(slot[m]), "+v"(gwr[m]));
        GtPtrs P = gt_ptrs([&](int r) { return arows + (size_t)(r < nvalid ? r : 0) * 256; },
                           [&](int c) { return WDT + (size_t)e * 262144 + (size_t)(it.nt0 * 256 + pcol(c)) * 256; });
        gt_issue2(lds, P, 4, koff);
        bool pre = false;
#pragma unroll 1
        for (int nt = it.nt0; nt < it.nt1; ++nt) {
            f32x4 acc[4][4]; zero_acc(acc);
            gt_run<8>(lds, acc, 4, P, koff, pre);
            if (nt + 1 < it.nt1) { gt_ptrs_b(P, [&](int c) { return WDT + (size_t)e * 262144 + (size_t)((nt + 1) * 256 + pcol(c)) * 256; }); gt_issue2(lds, P, 4, koff); }
            pre = nvalid == 128;
#pragma unroll
            for (int m = 0; m < 4; ++m) { const int r = wr * 64 + m * 16 + fr;
                if (r < nvalid) { const float gw = gwr[m];
                    bf16_t* yr = Y + (size_t)slot[m] * D + nt * 256 + wc * 64 + fq * 16;
                    *(u32x4*)yr = pk8(acc[m][0] * gw, acc[m][1] * gw); *(u32x4*)(yr + 8) = pk8(acc[m][2] * gw, acc[m][3] * gw); } }
        }
    }
}

DEV void combine_unit(char* lds, const Args& a, int t0, int nvalid, bool dry = false, bool write_h = true) {
    const int tid = otid(), lane = tid & 63, wid = tid >> 6;
    float* H = (float*)(a.ws + WS_H); bf16_t* HB = (bf16_t*)(a.ws + WS_A); float* RSTD = (float*)(a.ws + WS_RSTD); const bf16_t* Y = (const bf16_t*)(a.ws + WS_B);
#pragma unroll 4
    for (int i = 0; i < 16; ++i) {
        const int r = wid * 16 + i;
        if (r < nvalid) {
            const int t = t0 + r;
            float s = 0.f;
#pragma unroll
            for (int q = 0; q < 4; ++q) { const int col = q * 256 + lane * 4;
                f32x4 h = *(const f32x4*)(H + (size_t)t * D + col);
                const u32x2 y0 = *(const u32x2*)(Y + (size_t)(2 * t) * D + col), y1 = *(const u32x2*)(Y + (size_t)(2 * t + 1) * D + col);
                const float ys = dry ? 0.f : 1.f;
                h[0] += ys * (bflo(y0[0]) + bflo(y1[0])); h[1] += ys * (bfhi(y0[0]) + bfhi(y1[0])); h[2] += ys * (bflo(y0[1]) + bflo(y1[1])); h[3] += ys * (bfhi(y0[1]) + bfhi(y1[1]));
                if (write_h) *(f32x4*)(H + (size_t)t * D + col) = h;
                *(u32x2*)(HB + (size_t)t * D + col) = u32x2{pk2(h[0], h[1]), pk2(h[2], h[3])};
                s += h[0] * h[0] + h[1] * h[1] + h[2] * h[2] + h[3] * h[3]; }
            s = wave_sum(s);
            if (lane == 0) { const float rsv = rsqrtf(s * (1.f / D) + EPS); RSTD[t] = rsv; ((float*)(lds + LDS_TAB))[r] = rsv; }
        }
    }
}

template <int nt, class NEXT>
DEV void latent_tile(char* lds, const Args& a, int mt, const GtPtrs& P, bool pre, NEXT issue_next) {
    const int tid = otid(), lane = tid & 63, wid = tid >> 6, wr = wid >> 2, wc = wid & 3, fr = lane & 15, fq = lane >> 4;
    float* RSTDC = (float*)(a.ws + WS_RSTDC); float* SSQQ = (float*)(a.ws + WS_SSQQ);
    bf16_t* CRAW = (bf16_t*)(a.ws + WS_C); bf16_t* KR = (bf16_t*)(a.ws + WS_KR);
    const float* COS = (const float*)(a.ws + WS_COS); const float* SIN = (const float*)(a.ws + WS_SIN);
    {
        const int t0 = mt * 128, nvalid = mt < 256 ? 128 : 16;
        f32x4 acc[4][4]; zero_acc(acc);
        if (nvalid == 128) gt_run<8>(lds, acc, 16, P, [](int kc) { return kc * 64; }, pre); else gt_run<0, 3>(lds, acc, 16, P, [](int kc) { return kc * 64; }, false, nvalid);
        issue_next();
        const float* rstd_l = (const float*)(lds + LDS_TAB);
        float ssq[4] = {0.f, 0.f, 0.f, 0.f};
#pragma unroll
        for (int m = 0; m < 4; ++m) { const int r = wr * 64 + m * 16 + fr;
            if (r < nvalid) { const int t = t0 + r; const float rs = rstd_l[r];
#pragma unroll
                for (int n = 0; n < 4; ++n) acc[m][n] *= rs;
                if (nt == 1 && wc == 0) {
                    const int p = t < NREAL ? NMETA + (t & (SEQ - 1)) : t - NREAL;
#pragma unroll
                    for (int n = 0; n < 2; ++n) { const int i0 = fq * 8 + n * 4;
                        const f32x4 cs = *(const f32x4*)(COS + p * 32 + i0), sn = *(const f32x4*)(SIN + p * 32 + i0);
                        const f32x4 x1 = acc[m][n], x2 = acc[m][n + 2];
                        const f32x4 o1 = x1 * cs - x2 * sn, o2 = x1 * sn + x2 * cs;
                        const u32x2 w1 = {pk2(o1[0], o1[1]), pk2(o1[2], o1[3])}, w2 = {pk2(o2[0], o2[1]), pk2(o2[2], o2[3])};
                        if (t < NREAL) { bf16_t* kr = KR + ((size_t)(t >> 12) * LP + p) * 64 + i0; *(u32x2*)kr = w1; *(u32x2*)(kr + 32) = w2; }
                        else { for (int b = 0; b < NB; ++b) { bf16_t* kr = KR + ((size_t)b * LP + p) * 64 + i0; *(u32x2*)kr = w1; *(u32x2*)(kr + 32) = w2; } } }
                } else {
                    const int col = nt * 256 + wc * 64 + fq * 16;
                    if (col < 704) { const int cc = col < 256 ? col : col - 64;
                        *(u32x4*)(CRAW + (size_t)t * 640 + cc) = pk8(acc[m][0], acc[m][1]); *(u32x4*)(CRAW + (size_t)t * 640 + cc + 8) = pk8(acc[m][2], acc[m][3]);
#pragma unroll
                        for (int n = 0; n < 4; ++n)
                            ssq[m] += acc[m][n][0] * acc[m][n][0] + acc[m][n][1] * acc[m][n][1] + acc[m][n][2] * acc[m][n][2] + acc[m][n][3] * acc[m][n][3]; }
                } } }
        const float tot = tile_row_reduce(lds + LDS_RED, ssq);
        if (tid < nvalid) { const int t = t0 + tid;
            if (nt == 0) RSTDC[t] = rsqrtf(tot * (1.f / KVLR) + EPS);
            else if (t < NREAL) SSQQ[2 * t + (nt - 1)] = tot; }
    }
}

DEV void phase_comb_latent(char* lds, const Args& a, bool dry = false) {
    const bf16_t* HB = (const bf16_t*)(a.ws + WS_A); const bf16_t* WCAT = (const bf16_t*)(a.ws + WS_WCAT);
    auto koff = [](int kc) { return kc * 64; };
    for (int u = blockIdx.x; u < 256; u += gridDim.x) {
        combine_unit(lds, a, u * 128, 128, dry);
        __syncthreads();
        const int t0 = u * 128;
        auto arow = [&](int r) { return HB + (size_t)(t0 + r) * D; };
        GtPtrs P = gt_ptrs(arow, [&](int c) { return WCAT + (size_t)pcol(c) * 1024; });
        gt_issue2(lds, P, 16, koff);
        GtPtrs P1, P2;
        { int u0 = u; asm volatile("" : "+s"(u0));
          latent_tile<0>(lds, a, u0, P, false, [&]() { P1 = gt_ptrs(arow, [&](int c) { return WCAT + (size_t)(256 + (c < 64 ? rcol(c) : pcol(c))) * 1024; }); gt_issue2(lds, P1, 16, koff); }); }
        { int u1 = u; asm volatile("" : "+s"(u1));
          latent_tile<1>(lds, a, u1, P1, true, [&]() { P2 = gt_ptrs(arow, [&](int c) { return WCAT + (size_t)(512 + pcol(c)) * 1024; }); gt_issue2(lds, P2, 16, koff); }); }
        { int u2 = u; asm volatile("" : "+s"(u2)); latent_tile<2>(lds, a, u2, P2, true, [&]() {}); }
    }
    for (int j = blockIdx.x; j < 2; j += gridDim.x) {
        __syncthreads();
        combine_unit(lds, a, NREAL, 16, dry, false);
        __syncthreads();
        auto arow = [&](int r) { return HB + (size_t)(NREAL + (r < 16 ? r : 0)) * D; };
        if (j == 0) { const GtPtrs P = gt_ptrs(arow, [&](int c) { return WCAT + (size_t)pcol(c) * 1024; }); gt_issue2(lds, P, 16, koff);
            int u0 = 256; asm volatile("" : "+s"(u0)); latent_tile<0>(lds, a, u0, P, false, [&]() {}); }
        else { const GtPtrs P = gt_ptrs(arow, [&](int c) { return WCAT + (size_t)(256 + (c < 64 ? rcol(c) : pcol(c))) * 1024; }); gt_issue2(lds, P, 16, koff);
            int u1 = 256; asm volatile("" : "+s"(u1)); latent_tile<1>(lds, a, u1, P, false, [&]() {}); }
    }
}

DEV void phase_up(char* lds, const Args& a) {
    const int tid = otid(), lane = tid & 63, wid = tid >> 6, wr = wid >> 2, wc = wid & 3, fr = lane & 15, fq = lane >> 4;
    const bf16_t* CRAW = (const bf16_t*)(a.ws + WS_C); const bf16_t* WUKV = (const bf16_t*)(a.ws + WS_WUKV); const bf16_t* WUQ = (const bf16_t*)(a.ws + WS_WUQ);
    const float* RSTDC = (const float*)(a.ws + WS_RSTDC); const float* SSQQ = (const float*)(a.ws + WS_SSQQ);
    bf16_t* KN = (bf16_t*)(a.ws + WS_D); bf16_t* V = (bf16_t*)(a.ws + WS_A); bf16_t* Q = (bf16_t*)(a.ws + WS_B);
    const float* COS = (const float*)(a.ws + WS_COS); const float* SIN = (const float*)(a.ws + WS_SIN);
    { const int gt = blockIdx.x * NTHR + tid, GT = gridDim.x * NTHR;
      for (int i = gt; i < NB * 48 * 128; i += GT) { const int b = i / (48 * 128), r = i % (48 * 128);
          *(u32x4*)(V + ((size_t)b * LP + 4112) * 1024 + (size_t)r * 8) = u32x4{0u, 0u, 0u, 0u}; } }
    auto koff = [](int kc) { return kc * 64; };
    constexpr int NEPI = 8;
    for (int mt = blockIdx.x; mt < 256; mt += gridDim.x) {
        const int t0 = mt * 128, nvalid = 128; const bool full = true;
        auto arow_kv = [&](int r) { return CRAW + (size_t)(t0 + (r < nvalid ? r : 0)) * 640; };
        auto arow_q = [&](int r) { return CRAW + (size_t)(t0 + r) * 640 + 256; };
        float* rs_l = (float*)(lds + LDS_TAB);
        __syncthreads();
        { int tz = threadIdx.x; asm volatile("" : "+v"(tz));
          if (tz < 128) { const int t = t0 + (tz < nvalid ? tz : 0);
            rs_l[tz] = RSTDC[t]; rs_l[128 + tz] = full ? rsqrtf((SSQQ[2 * t] + SSQQ[2 * t + 1]) * (1.f / QLR) + EPS) : 0.f; } }
        __syncthreads();
        auto tile_ptrs = [&](int j) {
            if (j < 8) return gt_ptrs(arow_kv, [&](int c) { return WUKV + (size_t)(j * 256 + pcol(c)) * 256; });
            const int nq = j - 8;
            return gt_ptrs(arow_q, [&](int c) { return WUQ + (size_t)(nq * 256 + (((nq * 4 + (c >> 6)) % 3 == 2) ? rcol(c) : pcol(c))) * 384; });
        };
        GtStream S;
        GtPtrs P = tile_ptrs(0);
        gt_stream_begin(lds, S, P, koff);
#pragma unroll 1
        for (int j = 0; j < 14; ++j) {
            f32x4 acc[4][4]; zero_acc(acc);
            if (j > 0) P = tile_ptrs(j);
            gt_stream_tile<NEPI>(lds, S, acc, j < 8 ? 4 : 6, P, koff, j > 0, j < 13, [&]() { return tile_ptrs(j + 1); }, koff);
            const int tid = otid(), lane = tid & 63, wid = tid >> 6, wr = wid >> 2, wc = wid & 3, fr = lane & 15, fq = lane >> 4;
            if (j < 8) {
                const int nt = j;
                bf16_t* dst = nt < 4 ? KN : V;
#pragma unroll
                for (int m = 0; m < 4; ++m) { const int r = wr * 64 + m * 16 + fr; const int t = t0 + r; const float rs = rs_l[r];
                    const int colb = (nt & 3) * 256 + wc * 64 + fq * 16;
                    const u32x4 w0 = pk8(acc[m][0] * rs, acc[m][1] * rs), w1 = pk8(acc[m][2] * rs, acc[m][3] * rs);
                    bf16_t* o = dst + ((size_t)(t >> 12) * LP + NMETA + (t & (SEQ - 1))) * 1024 + colb; *(u32x4*)o = w0; *(u32x4*)(o + 8) = w1; }
            } else {
                const int nt = j - 8;
                const bool rope = ((nt * 4 + wc) % 3) == 2;
                if (rope) {
#pragma unroll
                    for (int m = 0; m < 4; ++m) { const int t = t0 + wr * 64 + m * 16 + fr; const int p = NMETA + (t & (SEQ - 1));
#pragma unroll
                        for (int n = 0; n < 2; ++n) { const int i0 = fq * 8 + n * 4;
                            const f32x4 cs = *(const f32x4*)(COS + p * 32 + i0), sn = *(const f32x4*)(SIN + p * 32 + i0);
                            const f32x4 x1 = acc[m][n], x2 = acc[m][n + 2];
                            acc[m][n] = x1 * cs - x2 * sn; acc[m][n + 2] = x1 * sn + x2 * cs; } }
                }
#pragma unroll
                for (int m = 0; m < 4; ++m) { const int t = t0 + wr * 64 + m * 16 + fr; const float rs = rs_l[128 + wr * 64 + m * 16 + fr];
                    bf16_t* o = Q + (size_t)t * 1536 + nt * 256 + wc * 64;
                    const u32x4 w0 = pk8(acc[m][0] * rs, acc[m][1] * rs), w1 = pk8(acc[m][2] * rs, acc[m][3] * rs);
                    if (rope) { *(u32x4*)(o + fq * 8) = w0; *(u32x4*)(o + 32 + fq * 8) = w1; }
                    else { *(u32x4*)(o + fq * 16) = w0; *(u32x4*)(o + fq * 16 + 8) = w1; } }
            }
        }
        gt_stream_end(S);
    }
    for (int j = blockIdx.x; j < 8; j += gridDim.x) {
        __syncthreads();
        const int nt = j;
        f32x4 acc[4][4]; zero_acc(acc);
        const GtPtrs P = gt_ptrs([&](int r) { return CRAW + (size_t)(NREAL + (r < 16 ? r : 0)) * 640; }, [&](int c) { return WUKV + (size_t)(nt * 256 + pcol(c)) * 256; });
        gt_issue2(lds, P, 4, koff);
        gt_run<0, 3>(lds, acc, 4, P, koff, false, 16);
        bf16_t* dst = nt < 4 ? KN : V;
        if (wr == 0) { const int r = fr; const float rs = RSTDC[NREAL + r];
            const int colb = (nt & 3) * 256 + wc * 64 + fq * 16;
            const u32x4 w0 = pk8(acc[0][0] * rs, acc[0][1] * rs), w1 = pk8(acc[0][2] * rs, acc[0][3] * rs);
            for (int b = 0; b < NB; ++b) { bf16_t* o = dst + ((size_t)b * LP + r) * 1024 + colb; *(u32x4*)o = w0; *(u32x4*)(o + 8) = w1; } }
    }
}

#if NAIVE_ATTN
DEV void phase_attn(char* lds, const Args& a) {
    (void)lds;
    const int tid = threadIdx.x, lane = tid & 63, wid = tid >> 6;
    bf16_t* Q = (bf16_t*)(a.ws + WS_B); const bf16_t* KN = (const bf16_t*)(a.ws + WS_D); const bf16_t* V = (const bf16_t*)(a.ws + WS_A); const bf16_t* KR = (const bf16_t*)(a.ws + WS_KR);
    const int nw = gridDim.x * 8;
    for (int task = blockIdx.x * 8 + wid; task < NB * NH * SEQ; task += nw) {
        const int s = task & (SEQ - 1), bh = task >> 12, b = bh >> 3, h = bh & 7;
        const int t = b * SEQ + s;
        bf16_t* q = Q + (size_t)t * 1536 + h * 192;
        const float q0 = bf2f(q[lane]), q1 = bf2f(q[lane + 64]), q2 = bf2f(q[128 + lane]);
        float mx = -1e30f, l = 0.f, o0 = 0.f, o1 = 0.f;
        const int nkeys = NMETA + s + 1;
        for (int j = 0; j < nkeys; ++j) {
            const size_t kr = (size_t)b * LP + j;
            const bf16_t* kn = KN + kr * 1024 + h * 128; const bf16_t* kp = KR + kr * 64; const bf16_t* vp = V + kr * 1024 + h * 128;
            float sc = q0 * bf2f(kn[lane]) + q1 * bf2f(kn[lane + 64]) + q2 * bf2f(kp[lane]);
            sc = wave_sum(sc) * ATTN_SCALE;
            const float mn = fmaxf(mx, sc), al = __expf(mx - mn), p = __expf(sc - mn);
            l = l * al + p; o0 = o0 * al + p * bf2f(vp[lane]); o1 = o1 * al + p * bf2f(vp[lane + 64]); mx = mn;
        }
        const float il = 1.f / l;
        const unsigned w0 = pk2(o0 * il, 0.f), w1 = pk2(o1 * il, 0.f);
        q[lane] = (bf16_t)(w0 & 0xffff); q[lane + 64] = (bf16_t)(w1 & 0xffff);
    }
}
#endif


#if !NAIVE_ATTN
namespace att {
typedef short s16x4 __attribute__((ext_vector_type(4)));
typedef float f32x16 __attribute__((ext_vector_type(16)));
constexpr int NW = 8, QBLK = 32, KVBLK = 64, QB = 256;
constexpr int SHM_V = 64 * 128 * 2, SHM_K = 64 * 192 * 2;
constexpr int QS = 1536, KNS = 1024, KRS = 64, VS = 1024, OS = 1536;
constexpr float THR = 8.f;
constexpr float SCALE = ATTN_SCALE;
constexpr int NQB = SEQ / QB;
#ifndef ATT_NQR
#define ATT_NQR 5
#endif
constexpr int NQR = ATT_NQR;
constexpr int Q_LDS = 2 * SHM_V + 2 * SHM_K + 2048;
#define KSWZ(row, colB) ((row) * 384 + ((colB) ^ ((((row) >> 1) & 7) << 4)))
#define SBAR() __builtin_amdgcn_sched_barrier(0)
DEV int v_st(int k, int c) { const int kk = (k & ~0xC) | ((k & 4) << 1) | ((k & 8) >> 1); return ((kk >> 3) * 4 + (c >> 5)) * 512 + ((kk & 7) * 32 + (c & 31)) * 2; }
DEV int v_rd_base(int lane) { return ((lane & 3) << 3) | (((lane >> 2) & 3) << 6) | (((lane >> 4) & 1) << 5) | (((lane >> 5) & 1) << 8); }
constexpr int v_rd_off(int d0, int ks, int half) { return d0 * 512 + ks * 4096 + half * 2048; }
DEV int crow(int r, int hi) { return (r & 3) + 8 * (r >> 2) + 4 * hi; }
DEV unsigned cvtpk(float lo, float hi) { unsigned r; asm volatile("v_cvt_pk_bf16_f32 %0, %1, %2" : "=v"(r) : "v"(lo), "v"(hi)); return r; }
DEV void mask_tile(f32x16& p0, f32x16& p1, int dq) {
    const float NEG = -__builtin_inff();
#pragma unroll
    for (int r = 0; r < 16; ++r) {
        const int c = (r & 3) + 8 * (r >> 2);
        if (dq - c < 0) p0[r] = NEG;
        if (dq - c - 32 < 0) p1[r] = NEG;
    }
}
DEV void partialSM(f32x16& p0, f32x16& p1, float& m_reg, float& mn, float& alpha) {
    float pmax = p0[0];
#pragma unroll
    for (int r = 1; r < 16; ++r) pmax = fmaxf(pmax, p0[r]);
#pragma unroll
    for (int r = 0; r < 16; ++r) pmax = fmaxf(pmax, p1[r]);
    { auto rr = __builtin_amdgcn_permlane32_swap(__float_as_uint(pmax), __float_as_uint(pmax), false, false);
      pmax = fmaxf(__uint_as_float(rr[0]), __uint_as_float(rr[1])); }
    constexpr float C2 = 1.4426950408889634f * SCALE;
    if (__builtin_expect(__all((pmax - m_reg) * SCALE <= THR), 1)) { mn = m_reg; alpha = 1.f; }
    else { mn = fmaxf(m_reg, pmax); alpha = __builtin_amdgcn_exp2f((m_reg - mn) * C2); m_reg = mn; }
    const float mnL = -mn * C2;
#pragma unroll
    for (int r = 0; r < 16; ++r) p0[r] = fmaf(p0[r], C2, mnL);
#pragma unroll
    for (int r = 0; r < 16; ++r) p1[r] = fmaf(p1[r], C2, mnL);
#pragma unroll
    for (int r = 0; r < 16; ++r) p0[r] = __builtin_amdgcn_exp2f(p0[r]);
}
DEV void finishSM(f32x16& p0, f32x16& p1, float alpha, float& l_reg, bf16x8& pa0, bf16x8& pa1, bf16x8& pa2, bf16x8& pa3) {
#pragma unroll
    for (int r = 0; r < 16; ++r) p1[r] = __builtin_amdgcn_exp2f(p1[r]);
    float ps = 0;
#pragma unroll
    for (int r = 0; r < 16; ++r) ps += p0[r];
#pragma unroll
    for (int r = 0; r < 16; ++r) ps += p1[r];
    { auto rr = __builtin_amdgcn_permlane32_swap(__float_as_uint(ps), __float_as_uint(ps), false, false);
      ps = __uint_as_float(rr[0]) + __uint_as_float(rr[1]); }
    l_reg = l_reg * alpha + ps;
#define PK4(P, B_, OUT) do { unsigned a0 = cvtpk(P[B_+0], P[B_+1]), a1 = cvtpk(P[B_+2], P[B_+3]);                          \
        unsigned b0 = cvtpk(P[B_+4], P[B_+5]), b1 = cvtpk(P[B_+6], P[B_+7]);                                             \
        auto r0 = __builtin_amdgcn_permlane32_swap(a0, b0, false, false); auto r1 = __builtin_amdgcn_permlane32_swap(a1, b1, false, false); \
        u32x4 w = {r0[0], r1[0], r0[1], r1[1]}; OUT = *reinterpret_cast<bf16x8*>(&w); } while (0)
    PK4(p0, 0, pa0); PK4(p0, 8, pa1); PK4(p1, 0, pa2); PK4(p1, 8, pa3);
#undef PK4
}
template <int KB>
DEV void qkt(f32x16& p0, f32x16& p1, const char* K_lds, int r32, int hi, const bf16x8* qr, const char* qlds) {
    p0 = f32x16{}; p1 = f32x16{};
    const char* kb[4];
#pragma unroll
    for (int dd = 0; dd < 4; ++dd) kb[dd] = K_lds + KB * SHM_K + KSWZ(r32, (dd * 16 + hi * 8) * 2);
#pragma unroll
    for (int d0 = 0; d0 < 12; ++d0) { const char* a = kb[d0 & 3] + (d0 >> 2) * 128;
        bf16x8 b0 = *reinterpret_cast<const bf16x8*>(a);
        bf16x8 b1 = *reinterpret_cast<const bf16x8*>(a + 32 * 384);
        bf16x8 q;
        if (d0 < NQR) q = qr[d0 < NQR ? d0 : 0]; else q = *reinterpret_cast<const bf16x8*>(qlds + (d0 - NQR) * 1024);
        p0 = __builtin_amdgcn_mfma_f32_32x32x16_bf16(b0, q, p0, 0, 0, 0);
        p1 = __builtin_amdgcn_mfma_f32_32x32x16_bf16(b1, q, p1, 0, 0, 0); }
}
template <int VB>
DEV void pv_tile(f32x16* o, int vb0, bf16x8 pa0, bf16x8 pa1, bf16x8 pa2, bf16x8 pa3) {
#define TRRD(dst, off) asm volatile("ds_read_b64_tr_b16 %0, %1 offset:%2" : "=&v"(dst) : "v"(vb0), "i"(off) : "memory")
#define PV_D0(d0) do { s16x4 l0, l1, l2, l3, h0, h1, h2, h3; constexpr int b_ = VB * SHM_V + v_rd_off(d0, 0, 0); \
        TRRD(l0, b_); TRRD(h0, b_ + 2048); TRRD(l1, b_ + 4096); TRRD(h1, b_ + 6144); TRRD(l2, b_ + 8192); TRRD(h2, b_ + 10240); TRRD(l3, b_ + 12288); TRRD(h3, b_ + 14336); \
        asm volatile("s_waitcnt lgkmcnt(0)" ::: "memory"); SBAR();   \
        o[d0] = __builtin_amdgcn_mfma_f32_32x32x16_bf16(pa0, (bf16x8){l0[0], l0[1], l0[2], l0[3], h0[0], h0[1], h0[2], h0[3]}, o[d0], 0, 0, 0);   \
        o[d0] = __builtin_amdgcn_mfma_f32_32x32x16_bf16(pa1, (bf16x8){l1[0], l1[1], l1[2], l1[3], h1[0], h1[1], h1[2], h1[3]}, o[d0], 0, 0, 0);   \
        o[d0] = __builtin_amdgcn_mfma_f32_32x32x16_bf16(pa2, (bf16x8){l2[0], l2[1], l2[2], l2[3], h2[0], h2[1], h2[2], h2[3]}, o[d0], 0, 0, 0);   \
        o[d0] = __builtin_amdgcn_mfma_f32_32x32x16_bf16(pa3, (bf16x8){l3[0], l3[1], l3[2], l3[3], h3[0], h3[1], h3[2], h3[3]}, o[d0], 0, 0, 0); } while (0)
    PV_D0(0); PV_D0(1); PV_D0(2); PV_D0(3);
#undef PV_D0
#undef TRRD
}
struct BlockRef { const bf16_t* Q; const bf16_t* Kn; const bf16_t* Kr; const bf16_t* V; bf16_t* O; int P0; };
struct Seam { bf16x8 qr[NQR]; bf16x8 st0, st1, st2; };
#define VMW() asm volatile("s_waitcnt vmcnt(0)" ::: "memory")
#define SLOAD_K(R, k0) do { const bf16_t* kn_ = (R).Kn + (size_t)(k0) * KNS; const bf16_t* kr2_ = (R).Kr + (size_t)(k0) * KRS; \
        S.st0 = *(const bf16x8*)(kn_ + offKn); S.st1 = *(const bf16x8*)(kn_ + offKn + 64); S.st2 = *(const bf16x8*)(kr2_ + offKr); } while (0)
#define SLOAD_V(R, k0) do { const bf16_t* vb_ = (R).V + (size_t)(k0) * VS; S.st0 = *(const bf16x8*)(vb_ + offV); S.st1 = *(const bf16x8*)(vb_ + offV + 32 * VS); } while (0)
#define SWRITE_K(bf) do { *(bf16x8*)(K_lds + (bf) * SHM_K + kws) = S.st0; *(bf16x8*)(K_lds + (bf) * SHM_K + kws + 128) = S.st1; *(bf16x8*)(K_lds + (bf) * SHM_K + kws + 256) = S.st2; } while (0)
#define SWRITE_V(bf) do { *(bf16x8*)(V_lds + (bf) * SHM_V + vst0) = S.st0; *(bf16x8*)(V_lds + (bf) * SHM_V + vst1) = S.st1; } while (0)
DEV void prime(const BlockRef& cur, char* lds, Seam& S) {
    const int tid = threadIdx.x;
    const int sr = tid >> 4, sc = (tid & 15) * 8, kr_ = tid >> 3, kc8 = (tid & 7) * 8, kws = KSWZ(kr_, kc8 * 2); char* K_lds = lds + 2 * SHM_V;
    const unsigned offV = sr * VS + sc, offKn = kr_ * KNS + kc8, offKr = kr_ * KRS + kc8;
    SLOAD_K(cur, 0); VMW(); SWRITE_K(0); SBAR(); SLOAD_V(cur, 0);
    __syncthreads();
}
DEV void block(const BlockRef& cur, const BlockRef& nxt, char* lds, Seam& S) {
    const int tid = threadIdx.x, wid = __builtin_amdgcn_readfirstlane(tid >> 6), lane = tid & 63, r32 = lane & 31, hi = lane >> 5;
    const int NT = (cur.P0 + QB - 1) / KVBLK + 1;
    const int qlo = cur.P0 + wid * QBLK, qm = qlo + r32 - 4 * hi;
    char* V_lds = lds; char* K_lds = lds + 2 * SHM_V;
    float* ws = (float*)(lds + 2 * SHM_V + 2 * SHM_K) + wid * 64; float* li_l = ws, * al_l = ws + 32;
    float m_reg = -1e30f, l_reg = 0; f32x16 o[4] = {};
    const int sr = tid >> 4, sc = (tid & 15) * 8, vst0 = v_st(sr, sc), vst1 = v_st(32 + sr, sc);
    const int kr_ = tid >> 3, kc8 = (tid & 7) * 8, kws = KSWZ(kr_, kc8 * 2);
    const unsigned offV = sr * VS + sc, offKn = kr_ * KNS + kc8, offKr = kr_ * KRS + kc8;
    const int vb0 = (int)(uintptr_t)V_lds + v_rd_base(lane);
#define RESC(a) do { if (__any((a) < 1.f)) { if (hi == 0) al_l[r32] = (a); asm volatile("s_waitcnt lgkmcnt(0)" ::: "memory");              \
                     for (int d_ = 0; d_ < 4; ++d_) for (int r = 0; r < 16; ++r) o[d_][r] *= al_l[crow(r, hi)]; } } while (0)
#define KBASE(t) ((t) * KVBLK)
#define MASKT(P0_, P1_, t) do { const int kb_ = KBASE(t); if (kb_ + KVBLK - 1 > qlo) mask_tile(P0_, P1_, qm - kb_); } while (0)
    f32x16 pA0, pA1, pB0, pB1; float mnA, mnB, alA, alB; bf16x8 pa0, pa1, pa2, pa3;
    char* qlds = lds + Q_LDS + wid * ((12 - NQR) * 1024) + lane * 16;
    VMW(); SWRITE_V(0); SBAR();
    { const bf16_t* qrow = cur.Q + (size_t)(wid * QBLK + r32) * QS + hi * 8;
#pragma unroll
      for (int d0 = 0; d0 < NQR; ++d0) S.qr[d0] = *(const bf16x8*)(qrow + d0 * 16);
#pragma unroll
      for (int d0 = NQR; d0 < 12; ++d0) { const bf16x8 tq = *(const bf16x8*)(qrow + d0 * 16); *(bf16x8*)(qlds + (d0 - NQR) * 1024) = tq; } }
    SBAR();
    SLOAD_K(cur, KBASE(1));
    SBAR(); qkt<0>(pA0, pA1, K_lds, r32, hi, S.qr, qlds);
    VMW(); SWRITE_K(1); SBAR(); SLOAD_V(cur, KBASE(1));
    MASKT(pA0, pA1, 0); partialSM(pA0, pA1, m_reg, mnA, alA);
    VMW(); SWRITE_V(1); SBAR(); SLOAD_K(cur, KBASE(2));
    __syncthreads();
#define HALF_STEP(PX0, PX1, mnX, alX, PY0, PY1, alY, t, KB, VB, SB) do {                                                      \
        SBAR(); qkt<KB>(PX0, PX1, K_lds, r32, hi, S.qr, qlds);                                                                \
        finishSM(PY0, PY1, alY, l_reg, pa0, pa1, pa2, pa3); SBAR();                                                           \
        if ((t) + 1 < NT) { VMW(); SWRITE_K(SB); SBAR(); SLOAD_V(cur, KBASE((t) + 1)); } SBAR();                              \
        pv_tile<VB>(o, vb0, pa0, pa1, pa2, pa3); MASKT(PX0, PX1, (t)); partialSM(PX0, PX1, m_reg, mnX, alX);                  \
        __syncthreads();                                                                                                      \
        if ((t) + 1 < NT) { VMW(); SWRITE_V(SB); SBAR(); if ((t) + 2 < NT) SLOAD_K(cur, KBASE((t) + 2)); }                    \
        RESC(alX); __syncthreads(); } while (0)
    for (int t = 1; t + 1 < NT; t += 2) {
        HALF_STEP(pB0, pB1, mnB, alB, pA0, pA1, alA, t, 1, 0, 0);
        HALF_STEP(pA0, pA1, mnA, alA, pB0, pB1, alB, t + 1, 0, 1, 1);
    }
    const bool even = (NT & 1) == 0;
    if (even) { SBAR(); qkt<1>(pB0, pB1, K_lds, r32, hi, S.qr, qlds); SBAR(); }
    SLOAD_K(nxt, 0); SBAR();
    finishSM(pA0, pA1, alA, l_reg, pa0, pa1, pa2, pa3); SBAR();
    pv_tile<0>(o, vb0, pa0, pa1, pa2, pa3);
    if (even) { MASKT(pB0, pB1, NT - 1); partialSM(pB0, pB1, m_reg, mnB, alB); __syncthreads(); RESC(alB);
        finishSM(pB0, pB1, alB, l_reg, pa0, pa1, pa2, pa3); SBAR(); pv_tile<1>(o, vb0, pa0, pa1, pa2, pa3); }
    SBAR(); VMW(); SWRITE_K(0); SBAR(); SLOAD_V(nxt, 0); SBAR();
    if (hi == 0) li_l[r32] = l_reg; asm volatile("s_waitcnt lgkmcnt(0)" ::: "memory");
    float rli[16];
#pragma unroll
    for (int r = 0; r < 16; ++r) rli[r] = __builtin_amdgcn_rcpf(li_l[crow(r, hi)]);
    bf16_t* Ow = cur.O + (size_t)(wid * QBLK) * OS;
#pragma unroll
    for (int r = 0; r < 16; ++r) { const int orow = crow(r, hi);
#pragma unroll
        for (int d0 = 0; d0 < 4; ++d0) { const float v = o[d0][r] * rli[r];
            const float vn = __shfl_xor(v, 1);
            if ((r32 & 1) == 0) *(unsigned*)(Ow + (size_t)orow * OS + d0 * 32 + r32) = cvtpk(v, vn); } }
    __syncthreads();
#undef RESC
#undef KBASE
#undef MASKT
#undef HALF_STEP
}
#undef VMW
#undef SLOAD_K
#undef SLOAD_V
#undef SWRITE_K
#undef SWRITE_V
}
DEV att::BlockRef attn_ref(const Args& a, int bh, int qb) {
    const int b = bh >> 3, h = bh & 7;
    att::BlockRef r;
    bf16_t* Q = (bf16_t*)(a.ws + WS_B);
    r.Q = Q + ((size_t)b * SEQ + (size_t)qb * 256) * 1536 + h * 192; r.O = Q + ((size_t)b * SEQ + (size_t)qb * 256) * 1536 + h * 192;
    r.Kn = (const bf16_t*)(a.ws + WS_D) + (size_t)b * LP * 1024 + h * 128; r.Kr = (const bf16_t*)(a.ws + WS_KR) + (size_t)b * LP * 64;
    r.V = (const bf16_t*)(a.ws + WS_A) + (size_t)b * LP * 1024 + h * 128; r.P0 = NMETA + qb * 256;
    return r;
}
DEV void phase_attn(char* lds, const Args& a) {
    const int total = NB * NH * 8, stride = gridDim.x;
    int L = vbid(); if (L >= total) return;
    int pass = 0;
    att::BlockRef cur = attn_ref(a, L >> 3, L & 7);
    att::Seam S;
    att::prime(cur, lds, S);
    for (;;) {
        const bool more_pass = pass == 0, more_item = L + stride < total, last = !more_pass && !more_item;
        int passn = pass + 1, Ln = L;
        if (!more_pass) { passn = 0; Ln = more_item ? L + stride : L; }
        const int yn = Ln & 7;
        const att::BlockRef nxt = last ? cur : attn_ref(a, Ln >> 3, passn ? 15 - yn : yn);
        att::block(cur, nxt, lds, S);
        if (last) break;
        cur = nxt; pass = passn; L = Ln;
    }
}
#endif

DEV void phase_wo_router(char* lds, const Args& a, bool dry = false) {
    const int tid = otid(), lane = tid & 63, wid = tid >> 6, wr = wid >> 2, wc = wid & 3, fr = lane & 15, fq = lane >> 4;
    const bf16_t* O = (const bf16_t*)(a.ws + WS_B); const bf16_t* WOT = (const bf16_t*)(a.ws + WS_WO);
    float* H = (float*)(a.ws + WS_H); bf16_t* HB = (bf16_t*)(a.ws + WS_A); float* RSTD = (float*)(a.ws + WS_RSTD);
    for (int u = blockIdx.x; u < 256; u += gridDim.x) {
        const int t0 = u * 128;
        float ssq[4] = {0.f, 0.f, 0.f, 0.f};
        f32x4 racc[4][3];
#pragma unroll
        for (int m = 0; m < 4; ++m)
#pragma unroll
            for (int n = 0; n < 3; ++n) racc[m][n] = f32x4{0.f, 0.f, 0.f, 0.f};
        const bf16_t* WH = (const bf16_t*)(a.ws + WS_WRT) + 98304; const bf16_t* WL = WH + 49152;
        auto koff = [](int kc) { return (kc >> 1) * 192 + (kc & 1) * 64; };
        auto arow = [&](int r) { return O + (size_t)(t0 + r) * 1536; };
        GtPtrs P = gt_ptrs(arow, [&](int c) { return WOT + (size_t)pcol(c) * 1024; });
        gt_issue2(lds, P, 16, koff);
        bool pre = false;
#pragma unroll 1
        for (int nt = 0; nt < 4; ++nt) {
            f32x4 acc[4][4]; zero_acc(acc);
            gt_run<16>(lds, acc, 16, P, koff, pre);
            f32x4 hh[4][4];
#pragma unroll
            for (int m = 0; m < 4; ++m) { const float* hr = H + (size_t)(t0 + wr * 64 + m * 16 + fr) * D + nt * 256 + wc * 64 + fq * 16;
#pragma unroll
                for (int n = 0; n < 4; ++n) hh[m][n] = *(const f32x4*)(hr + n * 4); }
            const float sc = dry ? 0.f : 1.f;
#pragma unroll
            for (int m = 0; m < 4; ++m)
#pragma unroll
                for (int n = 0; n < 4; ++n) hh[m][n] += acc[m][n] * sc;
            router_acc(racc, hh, WH, WL, nt * 256 + wc * 64, fr, fq);
#pragma unroll
            for (int m = 0; m < 4; ++m)
#pragma unroll
                for (int n = 0; n < 3; ++n) asm volatile("" : "+v"(racc[m][n]));
            if (nt < 3) { const int n1 = nt + 1; P = gt_ptrs(arow, [&](int c) { return WOT + (size_t)(n1 * 256 + pcol(c)) * 1024; }); gt_issue2(lds, P, 16, koff); }
            pre = true;
#pragma unroll
            for (int m = 0; m < 4; ++m) { const int t = t0 + wr * 64 + m * 16 + fr;
                const int col0 = nt * 256 + wc * 64 + fq * 16;
#pragma unroll
                for (int n = 0; n < 4; ++n) { const f32x4 h = hh[m][n];
                    *(f32x4*)(H + (size_t)t * D + col0 + n * 4) = h;
                    ssq[m] += h[0] * h[0] + h[1] * h[1] + h[2] * h[2] + h[3] * h[3]; }
                *(u32x4*)(HB + (size_t)t * D + col0) = pk8(hh[m][0], hh[m][1]); *(u32x4*)(HB + (size_t)t * D + col0 + 8) = pk8(hh[m][2], hh[m][3]); }
        }
        const float tot = tile_row_reduce(lds + LDS_RED, ssq);
        if (tid < 128) RSTD[t0 + tid] = rsqrtf(tot * (1.f / D) + EPS);
        router_part_store(lds, racc, wr, wc, fr, fq);
        __syncthreads();
        router_decide(lds, a, 1, t0, 128, dry);
    }
}

DEV void phase_final(const Args& a) {
    const int tid = otid(), lane = tid & 63, wid = tid >> 6;
    const float* H = (const float*)(a.ws + WS_H); const bf16_t* Y = (const bf16_t*)(a.ws + WS_B);
    for (int t = blockIdx.x * 8 + wid; t < NREAL; t += gridDim.x * 8) {
        f32x4 h[4]; float s = 0.f;
#pragma unroll
        for (int q = 0; q < 4; ++q) { const int col = q * 256 + lane * 4;
            h[q] = *(const f32x4*)(H + (size_t)t * D + col);
            const u32x2 y0 = *(const u32x2*)(Y + (size_t)(2 * t) * D + col), y1 = *(const u32x2*)(Y + (size_t)(2 * t + 1) * D + col);
            h[q][0] += bflo(y0[0]) + bflo(y1[0]); h[q][1] += bfhi(y0[0]) + bfhi(y1[0]); h[q][2] += bflo(y0[1]) + bflo(y1[1]); h[q][3] += bfhi(y0[1]) + bfhi(y1[1]);
            s += h[q][0] * h[q][0] + h[q][1] * h[q][1] + h[q][2] * h[q][2] + h[q][3] * h[q][3]; }
        s = wave_sum(s);
        const float rs = rsqrtf(s * (1.f / D) + EPS);
#pragma unroll
        for (int q = 0; q < 4; ++q) { const int col = q * 256 + lane * 4;
            const f32x4 g = *(const f32x4*)(a.final_norm + col);
            *(f32x4*)(a.out + (size_t)t * D + col) = h[q] * rs * g; }
    }
}


__global__ void __launch_bounds__(NTHR, 2) fwd(Args a) {
    extern __shared__ __attribute__((aligned(16))) char lds[];
    if (threadIdx.x == 0) *(u32x4*)(lds + LDS_XB) = u32x4{0u, 0u, 0u, 0u};
    __syncthreads();
    const bool multi = a.ph_hi - a.ph_lo > 1;
    XcdBarrier bar; bar.bar = (unsigned*)(a.ws + WS_CTL); bar.x = 0; bar.st = (volatile LAS unsigned*)(lds + LDS_XB);
    if (multi) bar = xcd_barrier_post((unsigned*)(a.ws + WS_CTL), (volatile LAS unsigned*)(lds + LDS_XB));
#define PHASE(i, call) if (a.ph_lo <= (i) && (i) < a.ph_hi) { if (a.ph_lo < (i)) xcd_barrier(bar); call; }
    PHASE(0, phase_prologue(lds, a))
    PHASE(1, phase_front(lds, a))
    PHASE(2, phase_moe1(lds, a, 0))
    PHASE(3, phase_moe2(lds, a, 0))
    PHASE(4, phase_comb_latent(lds, a))
    PHASE(5, phase_up(lds, a))
    PHASE(6, { phase_attn(lds, a); __syncthreads(); for (int i = blockIdx.x; i < TR_MOE; i += gridDim.x) tr_moe_job(lds, a, 1, i); })
    PHASE(7, phase_wo_router(lds, a))
    PHASE(8, phase_moe1(lds, a, 1))
    PHASE(9, phase_moe2(lds, a, 1))
    PHASE(10, phase_final(a))
#undef PHASE
}

extern "C" void kernel_launch(void* const* d_in, const int* in_sizes, int n_in, void* d_out, int out_size, void* d_ws, size_t ws_size, hipStream_t stream) {
    (void)in_sizes; (void)n_in; (void)out_size;
    static bool once = false;
    if (!once) { once = true;
        hipError_t e = hipFuncSetAttribute((const void*)fwd, hipFuncAttributeMaxDynamicSharedMemorySize, LDS_BYTES);
        if (e != hipSuccess) fprintf(stderr, "hipFuncSetAttribute: %s\n", hipGetErrorString(e));
        if (ws_size < WS_END) fprintf(stderr, "workspace too small: %zu < %zu\n", ws_size, (size_t)WS_END);
    }
    Args a{};
    const float* const* in = (const float* const*)d_in;
    a.x = in[0]; a.meta = in[1]; a.a_norm = in[2]; a.a_w = in[3]; a.a_scale = in[4];
    a.b_norm = in[5]; a.w_dq = in[6]; a.q_norm = in[7]; a.w_uq = in[8]; a.w_o = in[9];
    a.kv_norm = in[10]; a.w_dkv = in[11]; a.kv_lat_norm = in[12]; a.w_uk = in[13]; a.w_uv = in[14];
    a.ffn_norm = in[15]; a.router_g = in[16]; a.router_g_bias = in[17]; a.router_e = in[18]; a.router_e_bias = in[19];
    a.w_gate = in[20]; a.w_up = in[21]; a.w_down = in[22]; a.final_norm = in[23];
    a.out = (float*)d_out; a.ws = (unsigned char*)d_ws;
    (void)hipMemsetAsync(d_ws, 0, CTL_BYTES, stream);
    static int grid = 0;
    if (!grid) { int dev = 0, cus = 0, per_cu = 0;
        (void)hipGetDevice(&dev); (void)hipDeviceGetAttribute(&cus, hipDeviceAttributeMultiprocessorCount, dev);
        (void)hipOccupancyMaxActiveBlocksPerMultiprocessor(&per_cu, (const void*)fwd, NTHR, LDS_BYTES);
        if (cus <= 0) cus = 256;
        if (per_cu < 1) fprintf(stderr, "occupancy query says %d blocks per CU\n", per_cu);
        grid = cus;
    }
#if ONE_LAUNCH
    a.ph_lo = 0; a.ph_hi = NPHASE;
    hipLaunchKernelGGL(fwd, dim3(grid), dim3(NTHR), LDS_BYTES, stream, a);
#else
    for (int p = 0; p < NPHASE; ++p) { a.ph_lo = p; a.ph_hi = p + 1; hipLaunchKernelGGL(fwd, dim3(grid), dim3(NTHR), LDS_BYTES, stream, a); }
#endif
}
```

```cpp
#include <hip/hip_runtime.h>
#include <stdint.h>
#include <stdio.h>

#ifndef NAIVE_GEMM
#define NAIVE_GEMM 0
#endif
#ifndef NAIVE_ATTN
#define NAIVE_ATTN 0
#endif
#ifndef ONE_LAUNCH
#define ONE_LAUNCH 1
#endif

typedef unsigned short bf16_t;
typedef short bf16x8 __attribute__((ext_vector_type(8)));
typedef float f32x4 __attribute__((ext_vector_type(4)));
typedef float f32x2 __attribute__((ext_vector_type(2)));
typedef unsigned u32x4 __attribute__((ext_vector_type(4)));
typedef unsigned u32x2 __attribute__((ext_vector_type(2)));
#define DEV __device__ __forceinline__

constexpr int D = 1024, NB = 8, SEQ = 4096, NREAL = NB * SEQ, NMETA = 16, M1 = NREAL + NMETA;
constexpr int LP = 4160;
constexpr int NH = 8, DQK = 192, DNOPE = 128, DROPE = 64, DV = 128, QLR = 384, KVLR = 256;
constexpr int NE = 32, DE = 256;
constexpr int NSLOT = 2 * M1;
constexpr float EPS = 1e-6f;
constexpr float ATTN_SCALE = 0.07216878364870322f;
constexpr int NTHR = 512;
constexpr int LDS_BYTES = 163840;
constexpr int LDS_XB = LDS_BYTES - 16;
constexpr int NPHASE = 11;

constexpr size_t al256(size_t x) { return (x + 255) & ~(size_t)255; }
constexpr size_t WS_CTL = 0;
constexpr size_t CTL_BYTES = 32768;
constexpr size_t CTL_CNT = 16384;
constexpr size_t WS_LISTS = WS_CTL + CTL_BYTES;
constexpr size_t WS_GATEW = al256(WS_LISTS + (size_t)NE * M1 * 4);
constexpr size_t WS_RSTD = al256(WS_GATEW + (size_t)NSLOT * 4);
constexpr size_t WS_RSTDC = al256(WS_RSTD + (size_t)M1 * 4);
constexpr size_t WS_SSQQ = al256(WS_RSTDC + (size_t)M1 * 4);
constexpr size_t WS_COS = al256(WS_SSQQ + (size_t)NREAL * 8);
constexpr size_t WS_SIN = al256(WS_COS + (size_t)4112 * 32 * 4);
constexpr size_t WS_WR = al256(WS_SIN + (size_t)4112 * 32 * 4);
constexpr size_t WS_BIAS = al256(WS_WR + (size_t)2 * 1024 * 36 * 4);
constexpr size_t WS_WRT = al256(WS_BIAS + 512);
constexpr size_t WS_AWT = al256(WS_WRT + (size_t)2 * 2 * 48 * 1024 * 2);
constexpr size_t WS_WCAT = al256(WS_AWT + (size_t)4 * 256 * 256 * 2);
constexpr size_t WS_WUKV = al256(WS_WCAT + (size_t)768 * 1024 * 2);
constexpr size_t WS_WUQ = al256(WS_WUKV + (size_t)2048 * 256 * 2);
constexpr size_t WS_WO = al256(WS_WUQ + (size_t)1536 * 384 * 2);
constexpr size_t WS_WGU = al256(WS_WO + (size_t)1024 * 1024 * 2);
constexpr size_t WS_WD = al256(WS_WGU + (size_t)NE * 512 * 1024 * 2);
constexpr size_t WS_H = al256(WS_WD + (size_t)NE * 1024 * 256 * 2);
constexpr size_t WS_A = al256(WS_H + (size_t)M1 * D * 4);
constexpr size_t SZ_A = (size_t)NB * LP * 1024 * 2;
constexpr size_t WS_B = al256(WS_A + SZ_A);
constexpr size_t SZ_B = (size_t)NSLOT * 1024 * 2;
constexpr size_t WS_C = al256(WS_B + SZ_B);
constexpr size_t WS_KR = WS_C + (size_t)M1 * 640 * 2;
constexpr size_t SZ_C = (size_t)M1 * 640 * 2 + (size_t)NB * LP * 64 * 2;
constexpr size_t WS_D = al256(WS_C + SZ_C);
constexpr size_t SZ_D = (size_t)NB * LP * 1024 * 2;
constexpr size_t WS_END = WS_D + SZ_D;
static_assert((size_t)NREAL * 1536 * 2 <= SZ_B, "Q fits in region B");
static_assert((size_t)(NSLOT + 128) * 256 * 2 <= SZ_D, "ACT fits in region D");
static_assert((size_t)M1 * 1024 * 2 <= SZ_A, "HB fits in region A");

struct Args {
    const float* x; const float* meta; const float* a_norm; const float* a_w; const float* a_scale;
    const float* b_norm; const float* w_dq; const float* q_norm; const float* w_uq; const float* w_o;
    const float* kv_norm; const float* w_dkv; const float* kv_lat_norm; const float* w_uk; const float* w_uv;
    const float* ffn_norm; const float* router_g; const float* router_g_bias; const float* router_e; const float* router_e_bias;
    const float* w_gate; const float* w_up; const float* w_down; const float* final_norm;
    float* out; unsigned char* ws; int ph_lo, ph_hi;
};

DEV unsigned pk2(float lo, float hi) {
    typedef __bf16 b2 __attribute__((ext_vector_type(2)));
    f32x2 v = {lo, hi}; b2 b = __builtin_convertvector(v, b2); return __builtin_bit_cast(unsigned, b);
}
DEV float bf2f(unsigned short u) { return __uint_as_float((unsigned)u << 16); }
DEV float bflo(unsigned u) { return __uint_as_float(u << 16); }
DEV float bfhi(unsigned u) { return __uint_as_float(u & 0xffff0000u); }
DEV int otid() { int t = threadIdx.x; asm volatile("" : "+v"(t)); return t; }
DEV float wave_sum(float v) {
#pragma unroll
    for (int o = 32; o >= 1; o >>= 1) v += __shfl_xor(v, o);
    return v;
}
DEV const float* h0_row(const Args& a, int t) { return t < NREAL ? a.x + (size_t)t * D : a.meta + (size_t)(t - NREAL) * D; }
DEV const float* seq_row(const Args& a, int b, int p) { return p < NMETA ? a.meta + (size_t)p * D : a.x + ((size_t)b * SEQ + (p - NMETA)) * D; }

#define XB_TMO      128
#define XB_XCNT(j)  (256  + 64 * (j))
#define XB_XSUB(j)  (1280 + 64 * (j))
#define XB_XGEN(j)  (2304 + 64 * (j))
#define XB_TOP      3328
#define XB_TOPGEN   3392
#define XCD_BAR_WORDS 3456
#define XB_SPIN_CAP (1u << 18)
#define LAS __attribute__((address_space(3)))

__device__ __forceinline__ unsigned xb_ld(unsigned* p)              { return __hip_atomic_load(p, __ATOMIC_RELAXED, __HIP_MEMORY_SCOPE_AGENT); }
__device__ __forceinline__ unsigned xb_add(unsigned* p, unsigned v) { return __hip_atomic_fetch_add(p, v, __ATOMIC_RELAXED, __HIP_MEMORY_SCOPE_AGENT); }
__device__ __forceinline__ unsigned xb_xcc_id() { return (unsigned)__builtin_amdgcn_s_getreg((3 << 11) | 20) & 0xFu; }
#define XB_SPIN(cond, bar) do { unsigned _sp = 0; while (cond) { __builtin_amdgcn_s_sleep(1); \
    if ((++_sp & 255u) == 0u) { if (xb_ld(&(bar)[XB_TMO])) break; if (_sp > XB_SPIN_CAP) { atomicAdd(&(bar)[XB_TMO], 1u); break; } } } } while (0)

struct XcdBarrier { unsigned* bar; unsigned x; volatile LAS unsigned* st; };

__device__ __forceinline__ XcdBarrier xcd_barrier_post(unsigned* bar, volatile LAS unsigned* st) {
    XcdBarrier b; b.bar = bar; b.x = xb_xcc_id(); b.st = st;
    if (threadIdx.x == 0) (void)xb_add(&bar[XB_XCNT(b.x)], 1u);
    return b;
}
__device__ __forceinline__ void xcd_barrier_complete(unsigned* bar, unsigned x, unsigned& nloc, unsigned& nx) {
    const unsigned G = gridDim.x * gridDim.y * gridDim.z;
    unsigned sum, cnt, mine, sp = 0u;
    for (;;) {
        sum = 0u; cnt = 0u; mine = 0u;
#pragma unroll
        for (unsigned j = 0; j < 16; ++j) { const unsigned c = xb_ld(&bar[XB_XCNT(j)]); sum += c; cnt += (c > 0u) ? 1u : 0u; mine = (j == x) ? c : mine; }
        if (sum == G) break;
        __builtin_amdgcn_s_sleep(1);
        if ((++sp & 255u) == 0u) { if (xb_ld(&bar[XB_TMO])) break; if (sp > XB_SPIN_CAP) { atomicAdd(&bar[XB_TMO], 1u); break; } }
    }
    nloc = mine > 0u ? mine : 1u; nx = cnt > 0u ? cnt : 1u;
}
__device__ __forceinline__ void xcd_barrier(const XcdBarrier& b) {
    asm volatile("s_waitcnt vmcnt(0)" ::: "memory");
    __syncthreads();
    if (threadIdx.x == 0) {
        unsigned* bar = b.bar;
        __builtin_amdgcn_s_waitcnt(0);
        unsigned nloc = b.st[0], nx = b.st[1];
        if (nloc == 0u) { xcd_barrier_complete(bar, b.x, nloc, nx); b.st[0] = nloc; b.st[1] = nx; }
        const unsigned old = xb_add(&bar[XB_XSUB(b.x)], 1u);
        const unsigned gen = old / nloc;
        if (old + 1u == (gen + 1u) * nloc) {
            __builtin_amdgcn_fence(__ATOMIC_RELEASE, "agent");
            asm volatile("s_waitcnt vmcnt(0)" ::: "memory");
            const unsigned og = xb_add(&bar[XB_TOP], 1u);
            const unsigned tg = og / nx;
            if (og + 1u == (tg + 1u) * nx) xb_add(&bar[XB_TOPGEN], 1u);
            else XB_SPIN(xb_ld(&bar[XB_TOPGEN]) == tg, bar);
            __builtin_amdgcn_fence(__ATOMIC_ACQUIRE, "agent");
            xb_add(&bar[XB_XGEN(b.x)], 1u);
            asm volatile("s_waitcnt vmcnt(0)" ::: "memory");
        } else {
            XB_SPIN(xb_ld(&bar[XB_XGEN(b.x)]) == gen, bar);
            __builtin_amdgcn_fence(__ATOMIC_ACQUIRE, "agent");
            asm volatile("s_waitcnt vmcnt(0)" ::: "memory");
        }
    }
    __syncthreads();
}

constexpr int G_STAGE = 49152;
constexpr int G_LDS = 3 * G_STAGE;
template <int I, class AR, class BR, class KO>
DEV void naive_steps(f32x4 (&acc)[4][4], int nk, int mcnt, int wr, int wc, int fr, int fq, AR arow, BR brow, KO koff) {
    if constexpr (I < 64) {
        constexpr int m = I >> 4, n = (I >> 2) & 3, j = I & 3;
        if (m < mcnt) {
            const bf16_t* ap = arow(wr * 64 + m * 16 + fr);
            const bf16_t* bp = brow(wc * 64 + n * 16 + fq * 4 + j);
            float s = 0.f;
#pragma unroll 1
            for (int kc = 0; kc < nk; ++kc) {
                const u32x4* pa = (const u32x4*)(ap + koff(kc));
                const u32x4* pb = (const u32x4*)(bp + kc * 64);
#pragma unroll 2
                for (int c = 0; c < 8; ++c) {
                    const u32x4 va = pa[c], vb = pb[c];
#pragma unroll
                    for (int e = 0; e < 4; ++e) { s = fmaf(bflo(va[e]), bflo(vb[e]), s); s = fmaf(bfhi(va[e]), bfhi(vb[e]), s); }
                }
            }
            acc[m][n][j] += s;
        }
        naive_steps<I + 1>(acc, nk, mcnt, wr, wc, fr, fq, arow, brow, koff);
    }
}
struct GtPtrs { const bf16_t* pa0; const bf16_t* pa1; const bf16_t* pb0; const bf16_t* pb1; const bf16_t* pb2; const bf16_t* pb3; };
template <class AR, class BR>
DEV GtPtrs gt_ptrs(AR arow, BR brow) {
    const int tid = otid(), srow = tid >> 3, sx = ((tid & 7) ^ (srow & 7)) * 8;
    GtPtrs P; P.pa0 = arow(srow) + sx; P.pa1 = arow(srow + 64) + sx;
    P.pb0 = brow(srow) + sx; P.pb1 = brow(srow + 64) + sx; P.pb2 = brow(srow + 128) + sx; P.pb3 = brow(srow + 192) + sx;
    return P;
}
#define GLDS16(g, l) __builtin_amdgcn_global_load_lds((const unsigned*)(g), (unsigned*)(l), 16, 0, 0)
#define STAGE_T(so, kc) do { char* base_ = lds + (so) + threadIdx.x * 16; const int ka_ = koff(kc), kb_ = (kc) * 64; \
        GLDS16(P.pa0 + ka_, base_); GLDS16(P.pa1 + ka_, base_ + 8192); \
        GLDS16(P.pb0 + kb_, base_ + 16384); GLDS16(P.pb1 + kb_, base_ + 24576); GLDS16(P.pb2 + kb_, base_ + 32768); GLDS16(P.pb3 + kb_, base_ + 40960); } while (0)
template <class KO>
DEV void gt_issue2(char* lds, const GtPtrs& P, int nk, KO koff) {
    asm volatile("" ::: "memory");
    STAGE_T(0, 0);
    if (nk > 1) STAGE_T(G_STAGE, 1);
    asm volatile("" ::: "memory");
}
#define WAITV(n) asm volatile("s_waitcnt vmcnt(%0)" :: "i"(n) : "memory")
template <int NEPI, int MODE = 0, class KO>
DEV void gt_run(char* lds, f32x4 (&acc)[4][4], int nk, const GtPtrs& P, KO koff, bool pre, int nvalid = 128) {
    const int tid = threadIdx.x, lane = tid & 63, wid = tid >> 6, wr = wid >> 2, wc = wid & 3, fr = lane & 15, fq = lane >> 4;
    const int offk0 = ((fq ^ (fr & 7)) << 4), offk1 = (((4 + fq) ^ (fr & 7)) << 4);
    const int aoff = (wr * 64 + fr) * 128, boff = 16384 + (wc * 64 + fr) * 128;
    const int wru = __builtin_amdgcn_readfirstlane(wr);
    int mcnt = (nvalid - wru * 64 + 15) >> 4; mcnt = mcnt < 0 ? 0 : (mcnt > 4 ? 4 : mcnt);
#define GBAR() do { __builtin_amdgcn_sched_barrier(0); __builtin_amdgcn_s_barrier(); __builtin_amdgcn_sched_barrier(0); } while (0)
    if (NEPI > 0 && pre) { if (nk > 1) WAITV(6 + NEPI); else WAITV(NEPI); }
    else { if (nk > 1) WAITV(6); else WAITV(0); }
    GBAR();
    if (wru == 1) GBAR();
    int so = 0, so2 = 2 * G_STAGE;
#pragma unroll 1
    for (int t = 0; t < nk; ++t) {
        if (MODE != 2) { if (t + 2 < nk) STAGE_T(so2, t + 2); }
        const char* As = lds + so + aoff; const char* Bs = lds + so + boff;
        bf16x8 bq[4][2], aq[4][2];
        if (MODE != 3 || mcnt > 0) {
#pragma unroll
        for (int n = 0; n < 4; ++n) { bq[n][0] = *(const bf16x8*)(Bs + n * 2048 + offk0); bq[n][1] = *(const bf16x8*)(Bs + n * 2048 + offk1); }
#pragma unroll
        for (int m = 0; m < 4; ++m) { if (MODE != 3 || m == 0) { aq[m][0] = *(const bf16x8*)(As + m * 2048 + offk0); aq[m][1] = *(const bf16x8*)(As + m * 2048 + offk1); } }
        }
        if (NEPI > 0 && pre && t == 0) { if (t + 2 < nk) WAITV(6 + NEPI); else WAITV(NEPI); }
        else { if (t + 2 < nk) WAITV(6); else WAITV(0); }
        asm volatile("s_waitcnt lgkmcnt(0)" ::: "memory");
        GBAR();
        if (MODE == 1) {
#pragma unroll
            for (int m = 0; m < 4; ++m) { asm volatile("" :: "v"(aq[m][0]), "v"(aq[m][1]), "v"(bq[m][0]), "v"(bq[m][1])); }
        } else if (MODE == 3) {
            if (mcnt > 0) {
#pragma unroll
                for (int n = 0; n < 4; ++n) {
                    acc[0][n] = __builtin_amdgcn_mfma_f32_16x16x32_bf16(bq[n][0], aq[0][0], acc[0][n], 0, 0, 0);
                    acc[0][n] = __builtin_amdgcn_mfma_f32_16x16x32_bf16(bq[n][1], aq[0][1], acc[0][n], 0, 0, 0);
                }
            }
        } else {
        __builtin_amdgcn_s_setprio(1);
#pragma unroll
        for (int m = 0; m < 4; ++m)
#pragma unroll
            for (int n = 0; n < 4; ++n) {
                acc[m][n] = __builtin_amdgcn_mfma_f32_16x16x32_bf16(bq[n][0], aq[m][0], acc[m][n], 0, 0, 0);
                acc[m][n] = __builtin_amdgcn_mfma_f32_16x16x32_bf16(bq[n][1], aq[m][1], acc[m][n], 0, 0, 0);
            }
        __builtin_amdgcn_s_setprio(0);
        }
        GBAR();
        so2 = so; so = so + G_STAGE; if (so == 3 * G_STAGE) so = 0;
    }
    if (wru == 0) GBAR();
#undef GBAR
}
struct GtStream { int so; int wru; };
#define STAGE_PX(PP, KOFF, so_, kc) do { char* base_ = lds + (so_) + threadIdx.x * 16; const int ka_ = KOFF(kc), kb_ = (kc) * 64; \
        GLDS16((PP).pa0 + ka_, base_); GLDS16((PP).pa1 + ka_, base_ + 8192); \
        GLDS16((PP).pb0 + kb_, base_ + 16384); GLDS16((PP).pb1 + kb_, base_ + 24576); GLDS16((PP).pb2 + kb_, base_ + 32768); GLDS16((PP).pb3 + kb_, base_ + 40960); } while (0)
#define SBAR_() do { __builtin_amdgcn_sched_barrier(0); __builtin_amdgcn_s_barrier(); __builtin_amdgcn_sched_barrier(0); } while (0)
template <class KO>
DEV void gt_stream_begin(char* lds, GtStream& S, const GtPtrs& P, KO koff) {
    S.so = 0; S.wru = __builtin_amdgcn_readfirstlane((int)(threadIdx.x >> 8));
    asm volatile("" ::: "memory");
    STAGE_PX(P, koff, 0, 0); STAGE_PX(P, koff, G_STAGE, 1);
    asm volatile("" ::: "memory");
    WAITV(6);
    SBAR_();
    if (S.wru == 1) SBAR_();
}
template <int NEPI, class KO, class KON, class PNF>
DEV void gt_stream_tile(char* lds, GtStream& S, f32x4 (&acc)[4][4], int nk, const GtPtrs& P, KO koff, bool pre, bool has_next, PNF next_ptrs, KON koffn) {
    const int tid = threadIdx.x, lane = tid & 63, wid = tid >> 6, wr = wid >> 2, wc = wid & 3, fr = lane & 15, fq = lane >> 4;
    const int offk0 = ((fq ^ (fr & 7)) << 4), offk1 = (((4 + fq) ^ (fr & 7)) << 4);
    const int aoff = (wr * 64 + fr) * 128, boff = 16384 + (wc * 64 + fr) * 128;
    asm volatile("" ::: "memory");
    int so = S.so;
    GtPtrs Pn;
#pragma unroll 1
    for (int t = 0; t < nk; ++t) {
        int so2 = so + 2 * G_STAGE; if (so2 >= 3 * G_STAGE) so2 -= 3 * G_STAGE;
        const bool own = t + 2 < nk, nxt = !own && has_next;
        if (nxt && t + 2 == nk) Pn = next_ptrs();
        if (own) STAGE_PX(P, koff, so2, t + 2);
        else if (nxt) STAGE_PX(Pn, koffn, so2, t + 2 - nk);
        const char* As = lds + so + aoff; const char* Bs = lds + so + boff;
        bf16x8 bq[4][2], aq[4][2];
#pragma unroll
        for (int n = 0; n < 4; ++n) { bq[n][0] = *(const bf16x8*)(Bs + n * 2048 + offk0); bq[n][1] = *(const bf16x8*)(Bs + n * 2048 + offk1); }
#pragma unroll
        for (int m = 0; m < 4; ++m) { aq[m][0] = *(const bf16x8*)(As + m * 2048 + offk0); aq[m][1] = *(const bf16x8*)(As + m * 2048 + offk1); }
        if (t + 1 < nk || has_next) {
            if (NEPI > 0 && pre && t == 0) { if (own || nxt) WAITV(6 + NEPI); else WAITV(NEPI); }
            else { if (own || nxt) WAITV(6); else WAITV(0); }
        }
        asm volatile("s_waitcnt lgkmcnt(0)" ::: "memory");
        SBAR_();
        __builtin_amdgcn_s_setprio(1);
#pragma unroll
        for (int m = 0; m < 4; ++m)
#pragma unroll
            for (int n = 0; n < 4; ++n) {
                acc[m][n] = __builtin_amdgcn_mfma_f32_16x16x32_bf16(bq[n][0], aq[m][0], acc[m][n], 0, 0, 0);
                acc[m][n] = __builtin_amdgcn_mfma_f32_16x16x32_bf16(bq[n][1], aq[m][1], acc[m][n], 0, 0, 0);
            }
        __builtin_amdgcn_s_setprio(0);
        SBAR_();
        so += G_STAGE; if (so == 3 * G_STAGE) so = 0;
    }
    S.so = so;
    asm volatile("" ::: "memory");
}
DEV void gt_stream_end(GtStream& S) { if (S.wru == 0) SBAR_(); }
template <int MODE = 0, class AR, class BR, class KO>
DEV void gemm_tile(char* lds, f32x4 (&acc)[4][4], int nk, int nvalid, AR arow, BR brow, KO koff) {
    (void)nvalid;
#if NAIVE_GEMM
    const int tid = threadIdx.x, lane = tid & 63, wid = tid >> 6, wr = wid >> 2, wc = wid & 3, fr = lane & 15, fq = lane >> 4;
    naive_steps<0>(acc, nk, 4, wr, wc, fr, fq, arow, brow, koff);
#else
    const GtPtrs P = gt_ptrs(arow, brow);
    gt_issue2(lds, P, nk, koff);
    gt_run<0, MODE>(lds, acc, nk, P, koff, false);
#endif
}
DEV int pcol(int c) { return (c & 0xC3) | (((c >> 2) & 3) << 4) | (((c >> 4) & 3) << 2); }
DEV int rcol(int c) { const int n = (c >> 4) & 3, q = (c >> 2) & 3, e = c & 3; return (c & 0xC0) | ((n >> 1) << 5) | (q << 3) | ((n & 1) << 2) | e; }
DEV u32x4 pk8(f32x4 x, f32x4 y) { return u32x4{pk2(x[0], x[1]), pk2(x[2], x[3]), pk2(y[0], y[1]), pk2(y[2], y[3])}; }
DEV void zero_acc(f32x4 (&acc)[4][4]) {
#pragma unroll
    for (int m = 0; m < 4; ++m)
#pragma unroll
        for (int n = 0; n < 4; ++n) acc[m][n] = f32x4{0.f, 0.f, 0.f, 0.f};
}
DEV float tile_row_reduce(char* lds_red, const float (&ssq)[4]) {
    const int tid = otid(), lane = tid & 63, wid = tid >> 6, wr = wid >> 2, wc = wid & 3, fr = lane & 15, fq = lane >> 4;
    float* red = (float*)lds_red;
#pragma unroll
    for (int m = 0; m < 4; ++m) {
        float v = ssq[m]; v += __shfl_xor(v, 16); v += __shfl_xor(v, 32);
        if (fq == 0) red[(wr * 64 + m * 16 + fr) * 4 + wc] = v;
    }
    asm volatile("s_waitcnt lgkmcnt(0)" ::: "memory"); __builtin_amdgcn_s_barrier(); asm volatile("" ::: "memory");
    float r = 0.f;
    if (tid < 128) r = (red[tid * 4 + 0] + red[tid * 4 + 1]) + (red[tid * 4 + 2] + red[tid * 4 + 3]);
    asm volatile("s_waitcnt lgkmcnt(0)" ::: "memory"); __builtin_amdgcn_s_barrier(); asm volatile("" ::: "memory");
    return r;
}
constexpr int LDS_RED = G_LDS;
constexpr int LDS_TAB = G_LDS + 2048;


namespace pg8 {
#define PG8_LAS __attribute__((address_space(3)))
constexpr int BM = 256, BK = 64, HALF = 128, HTB = HALF * BK * 2, STAGE_BYTES = 8 * HTB;
DEV int lds_byte(int r, int c) { const int st = (r >> 4) * 2 + (c >> 5), rr = r & 15, cc = c & 31, ob = rr * 64 + cc * 2; return st * 1024 + (ob ^ (((ob >> 9) & 1) << 5)); }
DEV void stage_rc(int b, int& R, int& C) { const int st = b / 1024, sb = b % 1024, swz = sb ^ (((sb >> 9) & 1) << 5); R = (st >> 1) * 16 + swz / 64; C = (st & 1) * 32 + (swz % 64) / 2; }
DEV int perm32(int rho) { const int n = rho >> 4, i = rho & 15; return 8 * (i >> 2) + 4 * n + (i & 3); }
struct Unit { int pm, pn; };
template <class Epi, class Sched>
DEV void gemm_phase(char* lds_, int K, const Sched& S, const Epi& E) {
    PG8_LAS unsigned char* lds = (PG8_LAS unsigned char*)lds_;
    const int tid = threadIdx.x, wid = __builtin_amdgcn_readfirstlane(tid >> 6), lane = tid & 63, wr = wid >> 2, wc = wid & 3, fr = lane & 15, fq = lane >> 4;
    const int nt = K / BK;
    int sR[2], sC[2];
    unsigned voffA[2][2], voffAn[2][2], voffB[2][2], voffBn[2][2];
#pragma unroll
    for (int i = 0; i < 2; ++i) stage_rc(tid * 16 + i * 8192, sR[i], sC[i]);
    const size_t kstep = (size_t)(BK * 2);
    const unsigned ldsw = (unsigned)wid * 1024u;
    const int aoff = lds_byte(wr * 64 + fr, fq * 8), boff = lds_byte(wc * 32 + fr, fq * 8);
#define PG8_SA(b, h) (((b) * 2 + (h)) * HTB)
#define PG8_SB(b, h) ((4 + (b) * 2 + (h)) * HTB)
#define PG8_STAGEA(bufoff, gbase, h, usenext) do { _Pragma("unroll") for (int _i = 0; _i < 2; ++_i) \
        __builtin_amdgcn_global_load_lds((const unsigned*)((const char*)(gbase) + ((usenext) ? voffAn[h][_i] : voffA[h][_i])), (PG8_LAS unsigned*)(lds + (bufoff) + ldsw + _i * 8192), 16, 0, 0); } while (0)
#define PG8_STAGEB(bufoff, gbase, h, usenext) do { _Pragma("unroll") for (int _i = 0; _i < 2; ++_i) \
        __builtin_amdgcn_global_load_lds((const unsigned*)((const char*)(gbase) + ((usenext) ? voffBn[h][_i] : voffB[h][_i])), (PG8_LAS unsigned*)(lds + (bufoff) + ldsw + _i * 8192), 16, 0, 0); } while (0)
#define PG8_LDA(dst, b, h) do { _Pragma("unroll") for (int m = 0; m < 4; ++m) _Pragma("unroll") for (int k = 0; k < 2; ++k) dst[m][k] = *(const PG8_LAS bf16x8*)(lds + PG8_SA(b, h) + aoff + m * 2048 + k * 1024); } while (0)
#define PG8_LDB(dst, b, h) do { _Pragma("unroll") for (int n = 0; n < 2; ++n) _Pragma("unroll") for (int k = 0; k < 2; ++k) dst[n][k] = *(const PG8_LAS bf16x8*)(lds + PG8_SB(b, h) + boff + n * 2048 + k * 1024); } while (0)
#define PG8_MMA(ai, bj, At, Bt) do { __builtin_amdgcn_s_setprio(1); _Pragma("unroll") for (int m = 0; m < 4; ++m) _Pragma("unroll") for (int n = 0; n < 2; ++n) _Pragma("unroll") for (int k = 0; k < 2; ++k) \
        acc[ai][bj][m][n] = __builtin_amdgcn_mfma_f32_16x16x32_bf16(Bt[n][k], At[m][k], acc[ai][bj][m][n], 0, 0, 0); __builtin_amdgcn_s_setprio(0); } while (0)
#define PG8_WAIT_V(n) asm volatile("s_waitcnt vmcnt(" #n ")" ::: "memory")
#define PG8_WAIT_L(n) asm volatile("s_waitcnt lgkmcnt(" #n ")" ::: "memory")
#define PG8_BAR __builtin_amdgcn_s_barrier()
#define PG8_SCHED __builtin_amdgcn_sched_barrier(0)
    Unit cur, nxt; int ui = 0;
    if (!S.next(0, cur)) return;
    f32x4 acc[2][2][4][2];
#pragma unroll
    for (int a = 0; a < 2; ++a)
#pragma unroll
        for (int b = 0; b < 2; ++b)
#pragma unroll
            for (int m = 0; m < 4; ++m)
#pragma unroll
                for (int n = 0; n < 2; ++n) acc[a][b][m][n] = (f32x4){0.f, 0.f, 0.f, 0.f};
    bf16x8 At[4][2], B0[2][2], B1[2][2];
    const char* cA = S.a_base(cur); const char* cB = S.b_base(cur);
#pragma unroll
    for (int h = 0; h < 2; ++h)
#pragma unroll
        for (int i = 0; i < 2; ++i) { voffB[h][i] = (unsigned)((128 * h + S.b_row(cur, h, sR[i])) * K + sC[i]) * 2u;
            voffA[h][i] = (S.a_off(cur, h, sR[i]) + (unsigned)sC[i]) * 2u; }
    asm volatile("" ::: "memory");
    PG8_STAGEB(PG8_SB(0, 0), cB, 0, false); PG8_STAGEB(PG8_SB(0, 1), cB, 1, false); PG8_STAGEA(PG8_SA(0, 0), cA, 0, false); PG8_STAGEA(PG8_SA(0, 1), cA, 1, false);
    if (wr == 1) PG8_BAR;
    PG8_WAIT_V(2); PG8_BAR;
    PG8_STAGEB(PG8_SB(1, 0), cB + kstep, 0, false); PG8_STAGEA(PG8_SA(1, 0), cA + kstep, 0, false); PG8_STAGEB(PG8_SB(1, 1), cB + kstep, 1, false);
    PG8_WAIT_V(6); PG8_BAR;
    for (;;) {
        const bool has_next = S.next(ui + 1, nxt);
        const char* nA = has_next ? S.a_base(nxt) : cA; const char* nB = has_next ? S.b_base(nxt) : cB;
#pragma unroll
        for (int h = 0; h < 2; ++h)
#pragma unroll
            for (int i = 0; i < 2; ++i) { voffBn[h][i] = has_next ? (unsigned)((128 * h + S.b_row(nxt, h, sR[i])) * K + sC[i]) * 2u : voffB[h][i];
                voffAn[h][i] = has_next ? (S.a_off(nxt, h, sR[i]) + (unsigned)sC[i]) * 2u : voffA[h][i]; }
#pragma unroll 1
        for (int t = 0; t < nt; t += 2) {
            const bool last = (t == nt - 2);
            const char* a1 = cA + (size_t)(t + 1) * kstep;
            const char* a2 = last ? nA : cA + (size_t)(t + 2) * kstep; const char* b2 = last ? nB : cB + (size_t)(t + 2) * kstep;
            const char* a3 = a2 + kstep; const char* b3 = b2 + kstep;
            PG8_LDB(B0, 0, 0); PG8_LDB(B1, 0, 1); PG8_SCHED; PG8_LDA(At, 0, 0); PG8_STAGEA(PG8_SA(1, 1), a1, 1, false);
            PG8_WAIT_V(8); PG8_WAIT_L(0); PG8_BAR; PG8_MMA(0, 0, At, B0); PG8_MMA(0, 1, At, B1); PG8_BAR; PG8_SCHED;
            PG8_LDA(At, 0, 1); PG8_STAGEB(PG8_SB(0, 0), b2, 0, last); PG8_STAGEB(PG8_SB(0, 1), b2, 1, last); PG8_STAGEA(PG8_SA(0, 0), a2, 0, last);
            PG8_WAIT_V(8); PG8_WAIT_L(0); PG8_BAR; PG8_MMA(1, 0, At, B0); PG8_MMA(1, 1, At, B1); PG8_BAR; PG8_SCHED;
            PG8_LDB(B0, 1, 0); PG8_LDB(B1, 1, 1); PG8_SCHED; PG8_LDA(At, 1, 0); PG8_STAGEA(PG8_SA(0, 1), a2, 1, last);
            PG8_WAIT_V(8); PG8_WAIT_L(0); PG8_BAR; PG8_MMA(0, 0, At, B0); PG8_MMA(0, 1, At, B1); PG8_BAR; PG8_SCHED;
            PG8_LDA(At, 1, 1); PG8_STAGEB(PG8_SB(1, 0), b3, 0, last); PG8_STAGEB(PG8_SB(1, 1), b3, 1, last); PG8_STAGEA(PG8_SA(1, 0), a3, 0, last);
            PG8_WAIT_V(8); PG8_WAIT_L(0); PG8_BAR; PG8_MMA(1, 0, At, B0); PG8_MMA(1, 1, At, B1); PG8_BAR; PG8_SCHED;
        }
        if (wr == 0) PG8_BAR;
        E(acc, cur, wr, wc, fr, fq);
        if (!has_next) break;
#pragma unroll
        for (int a = 0; a < 2; ++a)
#pragma unroll
            for (int b = 0; b < 2; ++b)
#pragma unroll
                for (int m = 0; m < 4; ++m)
#pragma unroll
                    for (int n = 0; n < 2; ++n) acc[a][b][m][n] = (f32x4){0.f, 0.f, 0.f, 0.f};
        cur = nxt; cA = nA; cB = nB; ++ui;
#pragma unroll
        for (int h = 0; h < 2; ++h)
#pragma unroll
            for (int i = 0; i < 2; ++i) { voffB[h][i] = voffBn[h][i]; voffA[h][i] = voffAn[h][i]; }
        if (wr == 1) PG8_BAR;
    }
    PG8_WAIT_V(0);
    PG8_BAR;
#undef PG8_SA
#undef PG8_SB
#undef PG8_STAGEA
#undef PG8_STAGEB
#undef PG8_LDA
#undef PG8_LDB
#undef PG8_MMA
#undef PG8_WAIT_V
#undef PG8_WAIT_L
#undef PG8_BAR
#undef PG8_SCHED
}
}

DEV int rowmap(int mode, int n) { return mode == 0 ? n : ((n >> 7) * 256 + (n & 127) + (mode == 2 ? 128 : 0)); }
DEV void tr_tile(char* lds, const float* __restrict__ src, int ld, int k0, int n0, int nb, bf16_t* __restrict__ dst, int ldd, const float* sk, const float* sn, int mode) {
    const int tid = otid(), nl = tid & 63, kg = tid >> 6;
    float v[4][8];
#pragma unroll
    for (int j = 0; j < 4; ++j)
        if (j < nb) {
#pragma unroll
            for (int i = 0; i < 8; ++i) v[j][i] = src[(size_t)(k0 + kg * 8 + i) * ld + n0 + j * 64 + nl];
        }
    float skv[8];
#pragma unroll
    for (int i = 0; i < 8; ++i) skv[i] = sk ? sk[k0 + kg * 8 + i] : 1.f;
#pragma unroll
    for (int j = 0; j < 4; ++j)
        if (j < nb) {
            const float snv = sn ? sn[n0 + j * 64 + nl] : 1.f;
            const u32x4 w = {pk2(v[j][0] * skv[0] * snv, v[j][1] * skv[1] * snv), pk2(v[j][2] * skv[2] * snv, v[j][3] * skv[3] * snv),
                             pk2(v[j][4] * skv[4] * snv, v[j][5] * skv[5] * snv), pk2(v[j][6] * skv[6] * snv, v[j][7] * skv[7] * snv)};
            *(u32x4*)(lds + j * 9216 + nl * 144 + kg * 16) = w;
        }
    __syncthreads();
    const int r = tid >> 3, c = tid & 7;
#pragma unroll
    for (int j = 0; j < 4; ++j)
        if (j < nb) {
            const u32x4 o = *(const u32x4*)(lds + j * 9216 + r * 144 + c * 16);
            *(u32x4*)(dst + (size_t)rowmap(mode, n0 + j * 64 + r) * ldd + k0 + c * 8) = o;
        }
    __syncthreads();
}
constexpr int TR_SMALL = 212, TR_MOE = 1536;
DEV void tr_small_job(char* lds, const Args& a, int i) {
    unsigned char* ws = a.ws;
    if (i < 16) { const int g = i >> 2, kt = i & 3;
        tr_tile(lds, a.a_w + (size_t)g * 65536, 256, kt * 64, 0, 4, (bf16_t*)(ws + WS_AWT) + (size_t)g * 65536, 256, a.a_norm + g * 256, a.a_scale + g * 256, 0); return; }
    i -= 16;
    if (i < 32) { const int kt = i >> 1, h = i & 1;
        tr_tile(lds, a.w_dkv, 320, kt * 64, h * 256, h ? 1 : 4, (bf16_t*)(ws + WS_WCAT), 1024, a.kv_norm, nullptr, 0); return; }
    i -= 32;
    if (i < 32) { const int kt = i >> 1, h = i & 1;
        tr_tile(lds, a.w_dq, 384, kt * 64, h * 256, h ? 2 : 4, (bf16_t*)(ws + WS_WCAT) + (size_t)320 * 1024, 1024, a.b_norm, nullptr, 0); return; }
    i -= 32;
    if (i < 16) { const int kt = i >> 2, ng = i & 3;
        tr_tile(lds, a.w_uk, 1024, kt * 64, ng * 256, 4, (bf16_t*)(ws + WS_WUKV), 256, a.kv_lat_norm, nullptr, 0); return; }
    i -= 16;
    if (i < 16) { const int kt = i >> 2, ng = i & 3;
        tr_tile(lds, a.w_uv, 1024, kt * 64, ng * 256, 4, (bf16_t*)(ws + WS_WUKV) + (size_t)1024 * 256, 256, a.kv_lat_norm, nullptr, 0); return; }
    i -= 16;
    if (i < 36) { const int kt = i / 6, ng = i % 6;
        tr_tile(lds, a.w_uq, 1536, kt * 64, ng * 256, 4, (bf16_t*)(ws + WS_WUQ), 384, a.q_norm, nullptr, 0); return; }
    i -= 36;
    { const int kt = i >> 2, ng = i & 3;
        tr_tile(lds, a.w_o, 1024, kt * 64, ng * 256, 4, (bf16_t*)(ws + WS_WO), 1024, nullptr, nullptr, 0); }
}
DEV void tr_moe_job(char* lds, const Args& a, int l, int i) {
    unsigned char* ws = a.ws;
    const int e = i / 48, r = i % 48;
    const size_t eo = (size_t)(l * NE + e) * 262144;
    if (r < 32) { const int up = r >> 4, kt = r & 15;
        tr_tile(lds, (up ? a.w_up : a.w_gate) + eo, 256, kt * 64, 0, 4, (bf16_t*)(ws + WS_WGU) + (size_t)e * 524288, 1024, a.ffn_norm + l * 1024, nullptr, up ? 2 : 1); }
    else { const int rr = r - 32, kt = rr >> 2, ng = rr & 3;
        tr_tile(lds, a.w_down + eo, 1024, kt * 64, ng * 256, 4, (bf16_t*)(ws + WS_WD) + (size_t)e * 262144, 256, nullptr, nullptr, 0); }
}
DEV void phase_prologue(char* lds, const Args& a) {
    const int G = gridDim.x, bid = blockIdx.x, tid = threadIdx.x;
    unsigned char* ws = a.ws;
    const int gt = bid * NTHR + tid, GT = G * NTHR;
    bf16_t* WRT = (bf16_t*)(ws + WS_WRT);
    for (int i = gt; i < 2 * 48 * 1024; i += GT) { const int l = i / 49152, r = i % 49152, o = r >> 10, k = r & 1023;
        float w = 0.f;
        if (o < 36) w = (o < 4 ? a.router_g[(size_t)(l * 1024 + k) * 4 + o] : a.router_e[(size_t)(l * 1024 + k) * 32 + (o - 4)]) * a.ffn_norm[l * 1024 + k];
        const unsigned hi = pk2(w, 0.f) & 0xffffu; const float lo = w - __uint_as_float(hi << 16);
        WRT[(size_t)l * 98304 + r] = (bf16_t)hi; WRT[(size_t)l * 98304 + 49152 + r] = (bf16_t)(pk2(lo, 0.f) & 0xffffu); }
    float* BI = (float*)(ws + WS_BIAS);
    for (int i = gt; i < 128; i += GT) { const int l = i >> 6, o = i & 63; BI[i] = o < 4 ? a.router_g_bias[l * 4 + o] : (o < 36 ? a.router_e_bias[l * 32 + o - 4] : 0.f); }
    float* COS = (float*)(ws + WS_COS); float* SIN = (float*)(ws + WS_SIN);
    for (int i = gt; i < 4112 * 32; i += GT) { const int p = i >> 5, f = i & 31;
        const double inv = pow(10000.0, -(double)f / 32.0), ang = (double)p * inv; COS[i] = (float)cos(ang); SIN[i] = (float)sin(ang); }
    u32x4* wz = (u32x4*)((bf16_t*)(ws + WS_WCAT) + (size_t)704 * 1024);
    for (int i = gt; i < 64 * 1024 / 8; i += GT) wz[i] = u32x4{0u, 0u, 0u, 0u};
    for (int i = bid; i < TR_SMALL; i += G) tr_small_job(lds, a, i);
}

template <int W>
DEV void pool_cols(char* lds, const Args& a, int b, int pstart, int nrows, int first_out, bf16_t* __restrict__ po_base  , int c0) {
    const int tid = otid(), lane = tid & 63, wid = tid >> 6;
    float* part = (float*)lds;
    float* rsb = (float*)(lds + 512);
    f32x2 ring[16]; f32x2 sum = {0.f, 0.f};
#pragma unroll
    for (int j = 0; j < 16; ++j) ring[j] = f32x2{0.f, 0.f};
    f32x2 ldn[16];
#pragma unroll
    for (int j = 0; j < 16; ++j) { const int ii = j < nrows ? j : nrows - 1; ldn[j] = *(const f32x2*)(seq_row(a, b, pstart + ii) + c0); }
#pragma unroll 1
    for (int ib = 0; ib < nrows; ib += 16) {
        f32x2 ld[16];
#pragma unroll
        for (int j = 0; j < 16; ++j) ld[j] = ldn[j];
        if (ib + 16 < nrows) {
#pragma unroll
            for (int j = 0; j < 16; ++j) { const int i = ib + 16 + j; const int ii = i < nrows ? i : nrows - 1;
                ldn[j] = *(const f32x2*)(seq_row(a, b, pstart + ii) + c0); }
        }
#pragma unroll
        for (int j = 0; j < 16; ++j) { const float p = wave_sum(ld[j][0] * ld[j][0] + ld[j][1] * ld[j][1]); if (lane == 0) part[wid * 16 + j] = p; }
        asm volatile("s_waitcnt lgkmcnt(0)" ::: "memory"); __builtin_amdgcn_s_barrier(); asm volatile("" ::: "memory");
        if (tid < 16) { const float sq = ((part[tid] + part[16 + tid]) + (part[32 + tid] + part[48 + tid])) + ((part[64 + tid] + part[80 + tid]) + (part[96 + tid] + part[112 + tid]));
            rsb[tid] = rsqrtf(sq * (1.f / D) + EPS); }
        asm volatile("s_waitcnt lgkmcnt(0)" ::: "memory"); __builtin_amdgcn_s_barrier(); asm volatile("" ::: "memory");
#pragma unroll
        for (int j = 0; j < 16; ++j) { const int i = ib + j;
            if (i < nrows) {
                const float r = rsb[j]; const f32x2 v = {ld[j][0] * r, ld[j][1] * r};
                const f32x2 old = ring[(j - W) & 15];
                sum[0] += v[0] - old[0]; sum[1] += v[1] - old[1];
                ring[j] = v;
                if (i >= first_out) { const int pos = pstart + i; const float ic = 1.f / (float)(pos + 1 < W ? pos + 1 : W);
                    *(unsigned*)(po_base + (size_t)(i - first_out) * D + c0) = pk2(sum[0] * ic - v[0], sum[1] * ic - v[1]); }
            }
        }
    }
}
DEV void pool_unit(char* lds, const Args& a, int u) {
    const int tid = otid(), wid = tid >> 6;
    bf16_t* PO = (bf16_t*)(a.ws + WS_B);
    int b, pstart, nrows, first_out, t0;
    if (u < 256) { b = u >> 5; const int s0 = (u & 31) * 128; pstart = s0 + 1; nrows = 143; first_out = 15; t0 = u * 128; }
    else { b = 0; pstart = 0; nrows = 16; first_out = 0; t0 = NREAL; }
    __syncthreads();
    const int c0 = tid * 2, g = __builtin_amdgcn_readfirstlane(wid >> 1);
    bf16_t* pob = PO + (size_t)t0 * D;
    if (g == 0) pool_cols<2>(lds, a, b, pstart, nrows, first_out, pob, c0);
    else if (g == 1) pool_cols<4>(lds, a, b, pstart, nrows, first_out, pob, c0);
    else if (g == 2) pool_cols<8>(lds, a, b, pstart, nrows, first_out, pob, c0);
    else pool_cols<16>(lds, a, b, pstart, nrows, first_out, pob, c0);
    __syncthreads();
}

constexpr int R_PART = 0;
constexpr int R_HIST = 98304, R_ENT = R_HIST + 256;
DEV void router_acc(f32x4 (&racc)[4][3], const f32x4 (&hh)[4][4], const bf16_t* WH, const bf16_t* WL, int colbase, int fr, int fq) {
#pragma unroll
    for (int kk = 0; kk < 2; ++kk) {
        bf16x8 bh[3], bl[3];
#pragma unroll
        for (int n = 0; n < 3; ++n) { const size_t o = (size_t)(n * 16 + fr) * 1024 + colbase + fq * 16 + kk * 8; bh[n] = *(const bf16x8*)(WH + o); bl[n] = *(const bf16x8*)(WL + o); }
#pragma unroll
        for (int m = 0; m < 4; ++m) {
            const f32x4 v0 = hh[m][2 * kk], v1 = hh[m][2 * kk + 1];
            const unsigned h0 = pk2(v0[0], v0[1]), h1 = pk2(v0[2], v0[3]), h2 = pk2(v1[0], v1[1]), h3 = pk2(v1[2], v1[3]);
            const u32x4 hv = {h0, h1, h2, h3};
            const u32x4 lv = {pk2(v0[0] - bflo(h0), v0[1] - bfhi(h0)), pk2(v0[2] - bflo(h1), v0[3] - bfhi(h1)), pk2(v1[0] - bflo(h2), v1[1] - bfhi(h2)), pk2(v1[2] - bflo(h3), v1[3] - bfhi(h3))};
            const bf16x8 ah = __builtin_bit_cast(bf16x8, hv), al = __builtin_bit_cast(bf16x8, lv);
#pragma unroll
            for (int n = 0; n < 3; ++n) {
                racc[m][n] = __builtin_amdgcn_mfma_f32_16x16x32_bf16(ah, bh[n], racc[m][n], 0, 0, 0);
                racc[m][n] = __builtin_amdgcn_mfma_f32_16x16x32_bf16(al, bh[n], racc[m][n], 0, 0, 0);
                racc[m][n] = __builtin_amdgcn_mfma_f32_16x16x32_bf16(ah, bl[n], racc[m][n], 0, 0, 0);
            }
        }
    }
}
DEV void router_part_store(char* lds, const f32x4 (&racc)[4][3], int wr, int wc, int fr, int fq) {
    float* part = (float*)(lds + R_PART);
#pragma unroll
    for (int m = 0; m < 4; ++m)
#pragma unroll
        for (int n = 0; n < 3; ++n)
#pragma unroll
            for (int e = 0; e < 4; ++e) part[(wc * 128 + wr * 64 + m * 16 + fq * 4 + e) * 48 + n * 16 + fr] = racc[m][n][e];
}
DEV void mixer_unit(char* lds, const Args& a, int u) {
    const int tid = otid(), lane = tid & 63, wid = tid >> 6, wr = wid >> 2, wc = wid & 3, fr = lane & 15, fq = lane >> 4;
    const bf16_t* PO = (const bf16_t*)(a.ws + WS_B);
    const bf16_t* AWT = (const bf16_t*)(a.ws + WS_AWT);
    float* H = (float*)(a.ws + WS_H); bf16_t* HB = (bf16_t*)(a.ws + WS_A); float* RSTD = (float*)(a.ws + WS_RSTD);
    {
        const int t0 = u * 128, nvalid = u < 256 ? 128 : 16;
        float ssq[4] = {0.f, 0.f, 0.f, 0.f};
        f32x4 racc[4][3];
#pragma unroll
        for (int m = 0; m < 4; ++m)
#pragma unroll
            for (int n = 0; n < 3; ++n) racc[m][n] = f32x4{0.f, 0.f, 0.f, 0.f};
        const bf16_t* WH = (const bf16_t*)(a.ws + WS_WRT); const bf16_t* WL = WH + 49152;
        auto koff = [](int kc) { return kc * 64; };
        const bool full = nvalid == 128;
        { const GtPtrs P0 = gt_ptrs([&](int r) { return PO + (size_t)(t0 + (r < nvalid ? r : 0)) * D; }, [&](int c) { return AWT + (size_t)pcol(c) * 256; });
          gt_issue2(lds, P0, 4, koff); }
        bool pre = false;
#pragma unroll 1
        for (int g = 0; g < 4; ++g) {
            f32x4 acc[4][4]; zero_acc(acc);
            const GtPtrs P = gt_ptrs([&](int r) { return PO + (size_t)(t0 + (r < nvalid ? r : 0)) * D + g * 256; }, [&](int c) { return AWT + (size_t)g * 65536 + (size_t)pcol(c) * 256; });
            if (full) gt_run<16>(lds, acc, 4, P, koff, pre); else gt_run<0, 3>(lds, acc, 4, P, koff, false, nvalid);
            const int tid = otid(), lane = tid & 63, wid = tid >> 6, wr = wid >> 2, wc = wid & 3, fr = lane & 15, fq = lane >> 4;
            f32x4 hh[4][4];
#pragma unroll
            for (int m = 0; m < 4; ++m) { const int r = wr * 64 + m * 16 + fr; const float* hr = h0_row(a, t0 + (r < nvalid ? r : 0)) + g * 256 + wc * 64 + fq * 16;
#pragma unroll
                for (int n = 0; n < 4; ++n) hh[m][n] = *(const f32x4*)(hr + n * 4); }
#pragma unroll
            for (int m = 0; m < 4; ++m)
#pragma unroll
                for (int n = 0; n < 4; ++n) hh[m][n] += acc[m][n];
            router_acc(racc, hh, WH, WL, g * 256 + wc * 64, fr, fq);
#pragma unroll
            for (int m = 0; m < 4; ++m)
#pragma unroll
                for (int n = 0; n < 3; ++n) asm volatile("" : "+v"(racc[m][n]));
            if (g < 3) { const int g1 = g + 1;
                const GtPtrs Pn = gt_ptrs([&](int r) { return PO + (size_t)(t0 + (r < nvalid ? r : 0)) * D + g1 * 256; }, [&](int c) { return AWT + (size_t)g1 * 65536 + (size_t)pcol(c) * 256; });
                gt_issue2(lds, Pn, 4, koff); }
            pre = full;
#pragma unroll
            for (int m = 0; m < 4; ++m) { const int r = wr * 64 + m * 16 + fr;
                if (r < nvalid) { const int t = t0 + r;
                    const int col0 = g * 256 + wc * 64 + fq * 16;
#pragma unroll
                    for (int n = 0; n < 4; ++n) { const f32x4 h = hh[m][n];
                        *(f32x4*)(H + (size_t)t * D + col0 + n * 4) = h;
                        ssq[m] += h[0] * h[0] + h[1] * h[1] + h[2] * h[2] + h[3] * h[3]; }
                    *(u32x4*)(HB + (size_t)t * D + col0) = pk8(hh[m][0], hh[m][1]); *(u32x4*)(HB + (size_t)t * D + col0 + 8) = pk8(hh[m][2], hh[m][3]); } }
        }
        const float tot = tile_row_reduce(lds + LDS_RED, ssq);
        if (tid < nvalid) RSTD[t0 + tid] = rsqrtf(tot * (1.f / D) + EPS);
        router_part_store(lds, racc, wr, wc, fr, fq);
    }
}

DEV void router_decide(char* lds, const Args& a, int layer, int t0, int nvalid, bool dry) {
    const int tid = otid();
    const float* BI = (const float*)(a.ws + WS_BIAS) + layer * 64;
    const float* RSTD = (const float*)(a.ws + WS_RSTD);
    int* CNT = (int*)(a.ws + WS_CTL + CTL_CNT) + layer * 32; int* LISTS = (int*)(a.ws + WS_LISTS); float* GATEW = (float*)(a.ws + WS_GATEW);
    float* part = (float*)(lds + R_PART);
    int* hist = (int*)(lds + R_HIST); int* base = hist + 32; int* ent_e = (int*)(lds + R_ENT); int* ent_rank = ent_e + 256;
    if (tid < 32) hist[tid] = 0;
    __syncthreads();
    if (tid < nvalid) {
        const int t = t0 + tid; const float rs = RSTD[t];
        const float* p0 = part + tid * 48;
        float g[4];
#pragma unroll
        for (int i = 0; i < 4; ++i) g[i] = ((p0[i] + p0[6144 + i]) + (p0[12288 + i] + p0[18432 + i])) * rs + BI[i];
        int gs = 0; float gm = g[0];
#pragma unroll
        for (int i = 1; i < 4; ++i) if (g[i] > gm) { gm = g[i]; gs = i; }
        float den = 0.f;
#pragma unroll
        for (int i = 0; i < 4; ++i) den += __expf(g[i] - gm);
        const float wg = 1.f / den;
        float m1 = -3.0e38f, m2 = -3.0e38f; int i1 = 0, i2 = 0;
#pragma unroll
        for (int i = 0; i < 8; ++i) { const int o = 4 + gs * 8 + i;
            const float x = ((p0[o] + p0[6144 + o]) + (p0[12288 + o] + p0[18432 + o])) * rs + BI[o];
            if (x > m1) { m2 = m1; i2 = i1; m1 = x; i1 = i; } else if (x > m2) { m2 = x; i2 = i; } }
        const float ex = __expf(m2 - m1), s1 = 1.f / (1.f + ex), s2 = ex * s1;
        const int e1 = gs * 8 + i1, e2 = gs * 8 + i2;
        if (!dry) { GATEW[2 * t] = wg * s1; GATEW[2 * t + 1] = wg * s2; }
        ent_e[2 * tid] = e1; ent_rank[2 * tid] = atomicAdd(&hist[e1], 1);
        ent_e[2 * tid + 1] = e2; ent_rank[2 * tid + 1] = atomicAdd(&hist[e2], 1);
    }
    __syncthreads();
    if (tid < 32) base[tid] = (hist[tid] && !dry) ? atomicAdd(&CNT[tid], hist[tid]) : 0;
    __syncthreads();
    if (tid < 2 * nvalid && !dry) { const int e = ent_e[tid]; LISTS[(size_t)e * M1 + base[e] + ent_rank[tid]] = 2 * (t0 + (tid >> 1)) + (tid & 1); }
    __syncthreads();
}
DEV void router_tile(char* lds, const Args& a, int layer, int t0, int nvalid, bool dry = false) {
    const int tid = otid(), lane = tid & 63, wid = tid >> 6, fr = lane & 15, fq = lane >> 4;
    const bf16_t* WH = (const bf16_t*)(a.ws + WS_WRT) + (size_t)layer * 98304; const bf16_t* WL = WH + 49152;
    const float* BI = (const float*)(a.ws + WS_BIAS) + layer * 64;
    const float* H = (const float*)(a.ws + WS_H); const float* RSTD = (const float*)(a.ws + WS_RSTD);
    int* CNT = (int*)(a.ws + WS_CTL + CTL_CNT) + layer * 32; int* LISTS = (int*)(a.ws + WS_LISTS); float* GATEW = (float*)(a.ws + WS_GATEW);
    float* part = (float*)(lds + R_PART);
    int* hist = (int*)(lds + R_HIST); int* base = hist + 32; int* ent_e = (int*)(lds + R_ENT); int* ent_rank = ent_e + 256;
    if (tid < 32) hist[tid] = 0;
    const int kq = wid & 3, th = wid >> 2;
    f32x4 acc[4][3];
#pragma unroll
    for (int m = 0; m < 4; ++m)
#pragma unroll
        for (int n = 0; n < 3; ++n) acc[m][n] = f32x4{0.f, 0.f, 0.f, 0.f};
    const float* hrow[4];
#pragma unroll
    for (int m = 0; m < 4; ++m) { const int r = th * 64 + m * 16 + fr; hrow[m] = H + (size_t)(t0 + (r < nvalid ? r : 0)) * D + kq * 256 + fq * 8; }
#pragma unroll 2
    for (int s = 0; s < 8; ++s) {
        bf16x8 bh[3], bl[3];
#pragma unroll
        for (int n = 0; n < 3; ++n) { const size_t o = (size_t)(n * 16 + fr) * 1024 + kq * 256 + s * 32 + fq * 8;
            bh[n] = *(const bf16x8*)(WH + o); bl[n] = *(const bf16x8*)(WL + o); }
#pragma unroll
        for (int m = 0; m < 4; ++m) {
            if (__builtin_amdgcn_readfirstlane(th * 64 + m * 16) >= nvalid) continue;
            const f32x4 v0 = *(const f32x4*)(hrow[m] + s * 32), v1 = *(const f32x4*)(hrow[m] + s * 32 + 4);
            unsigned hw[4], lw[4];
#pragma unroll
            for (int e = 0; e < 2; ++e) {
                const unsigned h0 = pk2(v0[2 * e], v0[2 * e + 1]), h1 = pk2(v1[2 * e], v1[2 * e + 1]);
                hw[e] = h0; hw[2 + e] = h1;
                lw[e] = pk2(v0[2 * e] - bflo(h0), v0[2 * e + 1] - bfhi(h0)); lw[2 + e] = pk2(v1[2 * e] - bflo(h1), v1[2 * e + 1] - bfhi(h1));
            }
            const u32x4 hv = {hw[0], hw[1], hw[2], hw[3]}, lv = {lw[0], lw[1], lw[2], lw[3]};
            const bf16x8 ah = __builtin_bit_cast(bf16x8, hv), al = __builtin_bit_cast(bf16x8, lv);
#pragma unroll
            for (int n = 0; n < 3; ++n) {
                acc[m][n] = __builtin_amdgcn_mfma_f32_16x16x32_bf16(ah, bh[n], acc[m][n], 0, 0, 0);
                acc[m][n] = __builtin_amdgcn_mfma_f32_16x16x32_bf16(al, bh[n], acc[m][n], 0, 0, 0);
                acc[m][n] = __builtin_amdgcn_mfma_f32_16x16x32_bf16(ah, bl[n], acc[m][n], 0, 0, 0);
            }
        }
    }
#pragma unroll
    for (int m = 0; m < 4; ++m)
#pragma unroll
        for (int n = 0; n < 3; ++n)
#pragma unroll
            for (int e = 0; e < 4; ++e) part[(kq * 128 + th * 64 + m * 16 + fq * 4 + e) * 48 + n * 16 + fr] = acc[m][n][e];
    router_decide(lds, a, layer, t0, nvalid, dry);
}
DEV void phase_router(char* lds, const Args& a, int layer, int ntok) {
    const int nunits = (ntok + 127) >> 7;
    for (int u = blockIdx.x; u < nunits; u += gridDim.x) { const int t0 = u * 128; router_tile(lds, a, layer, t0, (ntok - t0) < 128 ? (ntok - t0) : 128); }
}

DEV void phase_front(char* lds, const Args& a, bool dry = false) {
    for (int u = blockIdx.x; u < 257; u += gridDim.x) {
        pool_unit(lds, a, u);
        mixer_unit(lds, a, u);
        __syncthreads();
        router_decide(lds, a, 0, u * 128, u < 256 ? 128 : 16, dry);
    }
    if (!dry && blockIdx.x > 0) { __syncthreads(); for (int i = blockIdx.x - 1; i < TR_MOE; i += gridDim.x - 1) tr_moe_job(lds, a, 0, i); }
}
DEV void moe_tables(char* lds, const Args& a, int layer) {
    int* tab = (int*)(lds + LDS_TAB); int* tstart = tab; int* rstart = tab + 33; int* cnt = tab + 66;
    int* CNT = (int*)(a.ws + WS_CTL + CTL_CNT) + layer * 32;
    if (threadIdx.x == 0) { int ts = 0, rsum = 0;
        for (int e = 0; e < 32; ++e) { const int c = __hip_atomic_load(&CNT[e], __ATOMIC_RELAXED, __HIP_MEMORY_SCOPE_AGENT); cnt[e] = c; tstart[e] = ts; rstart[e] = rsum; ts += (c + 127) >> 7; rsum += c; }
        tstart[32] = ts; rstart[32] = rsum; }
    __syncthreads();
}
DEV int vbid() { const int G = gridDim.x, b = blockIdx.x; return (G & 7) ? b : (b & 7) * (G >> 3) + (b >> 3); }
template <class BR>
DEV void gt_ptrs_b(GtPtrs& P, BR brow) {
    const int tid = otid(), srow = tid >> 3, sx = ((tid & 7) ^ (srow & 7)) * 8;
    P.pb0 = brow(srow) + sx; P.pb1 = brow(srow + 64) + sx; P.pb2 = brow(srow + 128) + sx; P.pb3 = brow(srow + 192) + sx;
}
struct MoeItem { int ti, nt0, nt1; };
template <int NTN>
DEV bool moe_item(int T, int k, MoeItem& it) {
    const int G = gridDim.x, v = vbid(), R = T / G, L = T - R * G;
    if (k < R) { it.ti = k * G + v; it.nt0 = 0; it.nt1 = NTN; return true; }
    const int s = v + G * (k - R);
    if (s >= L * NTN) return false;
    it.ti = R * G + s / NTN; it.nt0 = s % NTN; it.nt1 = it.nt0 + 1; return true;
}
constexpr int M2_TAB = 131072;
constexpr int M2_ROWS = M2_TAB + 512;
struct Moe1Sched { const char* lds; const bf16_t* HB; const bf16_t* WGU; int L0, L1, ti0;
    DEV void locate(int ti, int& e, int& tile) const { const int* t256 = (const int*)(lds + M2_TAB); e = 0; while (t256[e + 1] <= ti) ++e; tile = ti - t256[e]; }
    DEV bool next(int i, pg8::Unit& u) const { const int L = L0 + i; if (L >= L1) return false; u.pm = L >> 1; u.pn = L & 1; return true; }
    DEV const char* a_base(const pg8::Unit&) const { return (const char*)HB; }
    DEV const char* b_base(const pg8::Unit& u) const { int e, tile; locate(u.pm, e, tile); return (const char*)(WGU + (size_t)e * 524288 + (size_t)u.pn * 262144); }
    DEV unsigned a_off(const pg8::Unit& u, int h, int R) const { const int* rtok = (const int*)(lds + M2_ROWS) + (u.pm - ti0) * 256; const int t = rtok[128 * h + R]; return (unsigned)(t < 0 ? 0 : t) * 1024u; }
    DEV int b_row(const pg8::Unit&, int, int R) const { return (R & ~31) + pg8::perm32(R & 31); } };
struct Moe1Epi { const char* lds; bf16_t* ACT; int ti0;
    DEV void operator()(const f32x4 (&acc)[2][2][4][2], const pg8::Unit& u, int wr, int wc, int fr, int fq) const {
        const int* t256 = (const int*)(lds + M2_TAB); const int* rst = t256 + 33;
        int e = 0; while (t256[e + 1] <= u.pm) ++e; const int tile = u.pm - t256[e];
        const int* rtok = (const int*)(lds + M2_ROWS) + (u.pm - ti0) * 256; const float* rrs = (const float*)(lds + M2_ROWS + 3 * 1024) + (u.pm - ti0) * 256;
#pragma unroll
        for (int ai = 0; ai < 2; ++ai)
#pragma unroll
            for (int m = 0; m < 4; ++m) { const int r = ai * 128 + wr * 64 + m * 16 + fr;
                if (rtok[r] >= 0) { const float rs = rrs[r];
                    f32x4 o[2];
#pragma unroll
                    for (int n = 0; n < 2; ++n)
#pragma unroll
                        for (int j = 0; j < 4; ++j) { const float g = acc[ai][0][m][n][j] * rs, up = acc[ai][1][m][n][j] * rs; o[n][j] = g / (1.f + __expf(-g)) * up; }
                    *(u32x4*)(ACT + (size_t)(rst[e] + tile * 256 + r) * 256 + u.pn * 128 + wc * 32 + fq * 8) = pk8(o[0], o[1]); } }
    } };
DEV void phase_moe1(char* lds, const Args& a, int layer) {
    const int tid = otid();
    int* CNT = (int*)(a.ws + WS_CTL + CTL_CNT) + layer * 32;
    int* t256 = (int*)(lds + M2_TAB); int* rst = t256 + 33; int* cntl = t256 + 66;
    if (tid == 0) { int ts = 0, rsum = 0;
        for (int e = 0; e < 32; ++e) { const int c = __hip_atomic_load(&CNT[e], __ATOMIC_RELAXED, __HIP_MEMORY_SCOPE_AGENT); cntl[e] = c; t256[e] = ts; rst[e] = rsum; ts += (c + 255) >> 8; rsum += c; }
        t256[32] = ts; rst[32] = rsum; }
    __syncthreads();
    const int Ut = t256[32] * 2, G = gridDim.x, c = vbid(), q = Ut / G, rem = Ut % G;
    const int L0 = c * q + (c < rem ? c : rem), L1 = L0 + q + (c < rem ? 1 : 0);
    const int ti0 = L0 >> 1, ti1 = L1 > L0 ? ((L1 - 1) >> 1) : ti0 - 1;
    const int* LISTS = (const int*)(a.ws + WS_LISTS); const float* RSTD = (const float*)(a.ws + WS_RSTD);
    int* rtok = (int*)(lds + M2_ROWS); float* rrs = (float*)(lds + M2_ROWS + 3 * 1024);
    for (int k = 0; k <= ti1 - ti0 && k < 3; ++k) {
        const int ti = ti0 + k; int e = 0; while (t256[e + 1] <= ti) ++e; const int tile = ti - t256[e];
        if (tid < 256) { const int r = tile * 256 + tid; const bool ok = r < cntl[e];
            const int tok = ok ? (LISTS[(size_t)e * M1 + r] >> 1) : -1; rtok[k * 256 + tid] = tok; rrs[k * 256 + tid] = ok ? RSTD[tok] : 0.f; } }
    __syncthreads();
    const Moe1Sched S{lds, (const bf16_t*)(a.ws + WS_A), (const bf16_t*)(a.ws + WS_WGU), L0, (ti1 - ti0 < 3) ? L1 : L0, ti0};
    const Moe1Epi E{lds, (bf16_t*)(a.ws + WS_D), ti0};
    pg8::gemm_phase(lds, 1024, S, E);
}

struct Moe2Sched { const char* lds; const bf16_t* ACT; const bf16_t* WDT; int L0, L1;
    DEV void locate(int ti, int& e, int& tile) const { const int* t256 = (const int*)(lds + M2_TAB); e = 0; while (t256[e + 1] <= ti) ++e; tile = ti - t256[e]; }
    DEV bool next(int i, pg8::Unit& u) const { const int L = L0 + i; if (L >= L1) return false; u.pm = L >> 2; u.pn = L & 3; return true; }
    DEV const char* a_base(const pg8::Unit& u) const { int e, tile; locate(u.pm, e, tile); const int* rst = (const int*)(lds + M2_TAB) + 33; return (const char*)(ACT + (size_t)(rst[e] + tile * 256) * 256); }
    DEV const char* b_base(const pg8::Unit& u) const { int e, tile; locate(u.pm, e, tile); return (const char*)(WDT + (size_t)e * 262144 + (size_t)u.pn * 65536); }
    DEV unsigned a_off(const pg8::Unit&, int h, int R) const { return (unsigned)((128 * h + R) * 256); }
    DEV int b_row(const pg8::Unit&, int, int R) const { return (R & ~31) + pg8::perm32(R & 31); } };
struct Moe2Epi { const char* lds; bf16_t* Y; int ti0;
    DEV void operator()(const f32x4 (&acc)[2][2][4][2], const pg8::Unit& u, int wr, int wc, int fr, int fq) const {
        const int* rslot = (const int*)(lds + M2_ROWS) + (u.pm - ti0) * 256; const float* rgw = (const float*)(lds + M2_ROWS + 3 * 1024) + (u.pm - ti0) * 256;
#pragma unroll
        for (int ai = 0; ai < 2; ++ai)
#pragma unroll
            for (int m = 0; m < 4; ++m) { const int r = ai * 128 + wr * 64 + m * 16 + fr; const int slot = rslot[r];
                if (slot >= 0) { const float gw = rgw[r]; bf16_t* yr = Y + (size_t)slot * D + u.pn * 256 + wc * 32 + fq * 8;
#pragma unroll
                    for (int bj = 0; bj < 2; ++bj) *(u32x4*)(yr + bj * 128) = pk8(acc[ai][bj][m][0] * gw, acc[ai][bj][m][1] * gw); } }
    } };
DEV void phase_moe2(char* lds, const Args& a, int layer) {
    const int tid = otid();
    int* CNT = (int*)(a.ws + WS_CTL + CTL_CNT) + layer * 32;
    int* t256 = (int*)(lds + M2_TAB); int* rst = t256 + 33; int* cntl = t256 + 66;
    if (tid == 0) { int ts = 0, rsum = 0;
        for (int e = 0; e < 32; ++e) { const int c = __hip_atomic_load(&CNT[e], __ATOMIC_RELAXED, __HIP_MEMORY_SCOPE_AGENT); cntl[e] = c; t256[e] = ts; rst[e] = rsum; ts += (c + 255) >> 8; rsum += c; }
        t256[32] = ts; rst[32] = rsum; }
    __syncthreads();
    const int Ut = t256[32] * 4, G = gridDim.x, c = vbid(), q = Ut / G, rem = Ut % G;
    const int L0 = c * q + (c < rem ? c : rem), L1 = L0 + q + (c < rem ? 1 : 0);
    const int ti0 = L0 >> 2, ti1 = L1 > L0 ? ((L1 - 1) >> 2) : ti0 - 1;
    const int* LISTS = (const int*)(a.ws + WS_LISTS); const float* GATEW = (const float*)(a.ws + WS_GATEW);
    int* rslot = (int*)(lds + M2_ROWS); float* rgw = (float*)(lds + M2_ROWS + 3 * 1024);
    for (int k = 0; k <= ti1 - ti0 && k < 3; ++k) {
        const int ti = ti0 + k; int e = 0; while (t256[e + 1] <= ti) ++e; const int tile = ti - t256[e];
        if (tid < 256) { const int r = tile * 256 + tid; const bool ok = r < cntl[e];
            const int sl = ok ? LISTS[(size_t)e * M1 + r] : -1; rslot[k * 256 + tid] = sl; rgw[k * 256 + tid] = ok ? GATEW[sl] : 0.f; } }
    __syncthreads();
    const Moe2Sched S{lds, (const bf16_t*)(a.ws + WS_D), (const bf16_t*)(a.ws + WS_WD), L0, (ti1 - ti0 < 3) ? L1 : L0};
    const Moe2Epi E{lds, (bf16_t*)(a.ws + WS_B), ti0};
    pg8::gemm_phase(lds, 256, S, E);
}

DEV void combine_unit(char* lds, const Args& a, int t0, int nvalid, bool dry = false, bool write_h = true) {
    const int tid = otid(), lane = tid & 63, wid = tid >> 6;
    float* H = (float*)(a.ws + WS_H); bf16_t* HB = (bf16_t*)(a.ws + WS_A); float* RSTD = (float*)(a.ws + WS_RSTD); const bf16_t* Y = (const bf16_t*)(a.ws + WS_B);
#pragma unroll 4
    for (int i = 0; i < 16; ++i) {
        const int r = wid * 16 + i;
        if (r < nvalid) {
            const int t = t0 + r;
            float s = 0.f;
#pragma unroll
            for (int q = 0; q < 4; ++q) { const int col = q * 256 + lane * 4;
                f32x4 h = *(const f32x4*)(H + (size_t)t * D + col);
                const u32x2 y0 = *(const u32x2*)(Y + (size_t)(2 * t) * D + col), y1 = *(const u32x2*)(Y + (size_t)(2 * t + 1) * D + col);
                const float ys = dry ? 0.f : 1.f;
                h[0] += ys * (bflo(y0[0]) + bflo(y1[0])); h[1] += ys * (bfhi(y0[0]) + bfhi(y1[0])); h[2] += ys * (bflo(y0[1]) + bflo(y1[1])); h[3] += ys * (bfhi(y0[1]) + bfhi(y1[1]));
                if (write_h) *(f32x4*)(H + (size_t)t * D + col) = h;
                *(u32x2*)(HB + (size_t)t * D + col) = u32x2{pk2(h[0], h[1]), pk2(h[2], h[3])};
                s += h[0] * h[0] + h[1] * h[1] + h[2] * h[2] + h[3] * h[3]; }
            s = wave_sum(s);
            if (lane == 0) { const float rsv = rsqrtf(s * (1.f / D) + EPS); RSTD[t] = rsv; ((float*)(lds + LDS_TAB))[r] = rsv; }
        }
    }
}

template <int nt, class NEXT>
DEV void latent_tile(char* lds, const Args& a, int mt, const GtPtrs& P, bool pre, NEXT issue_next) {
    const int tid = otid(), lane = tid & 63, wid = tid >> 6, wr = wid >> 2, wc = wid & 3, fr = lane & 15, fq = lane >> 4;
    float* RSTDC = (float*)(a.ws + WS_RSTDC); float* SSQQ = (float*)(a.ws + WS_SSQQ);
    bf16_t* CRAW = (bf16_t*)(a.ws + WS_C); bf16_t* KR = (bf16_t*)(a.ws + WS_KR);
    const float* COS = (const float*)(a.ws + WS_COS); const float* SIN = (const float*)(a.ws + WS_SIN);
    {
        const int t0 = mt * 128, nvalid = mt < 256 ? 128 : 16;
        f32x4 acc[4][4]; zero_acc(acc);
        if (nvalid == 128) gt_run<8>(lds, acc, 16, P, [](int kc) { return kc * 64; }, pre); else gt_run<0, 3>(lds, acc, 16, P, [](int kc) { return kc * 64; }, false, nvalid);
        issue_next();
        const float* rstd_l = (const float*)(lds + LDS_TAB);
        float ssq[4] = {0.f, 0.f, 0.f, 0.f};
#pragma unroll
        for (int m = 0; m < 4; ++m) { const int r = wr * 64 + m * 16 + fr;
            if (r < nvalid) { const int t = t0 + r; const float rs = rstd_l[r];
#pragma unroll
                for (int n = 0; n < 4; ++n) acc[m][n] *= rs;
                if (nt == 1 && wc == 0) {
                    const int p = t < NREAL ? NMETA + (t & (SEQ - 1)) : t - NREAL;
#pragma unroll
                    for (int n = 0; n < 2; ++n) { const int i0 = fq * 8 + n * 4;
                        const f32x4 cs = *(const f32x4*)(COS + p * 32 + i0), sn = *(const f32x4*)(SIN + p * 32 + i0);
                        const f32x4 x1 = acc[m][n], x2 = acc[m][n + 2];
                        const f32x4 o1 = x1 * cs - x2 * sn, o2 = x1 * sn + x2 * cs;
                        const u32x2 w1 = {pk2(o1[0], o1[1]), pk2(o1[2], o1[3])}, w2 = {pk2(o2[0], o2[1]), pk2(o2[2], o2[3])};
                        if (t < NREAL) { bf16_t* kr = KR + ((size_t)(t >> 12) * LP + p) * 64 + i0; *(u32x2*)kr = w1; *(u32x2*)(kr + 32) = w2; }
                        else { for (int b = 0; b < NB; ++b) { bf16_t* kr = KR + ((size_t)b * LP + p) * 64 + i0; *(u32x2*)kr = w1; *(u32x2*)(kr + 32) = w2; } } }
                } else {
                    const int col = nt * 256 + wc * 64 + fq * 16;
                    if (col < 704) { const int cc = col < 256 ? col : col - 64;
                        *(u32x4*)(CRAW + (size_t)t * 640 + cc) = pk8(acc[m][0], acc[m][1]); *(u32x4*)(CRAW + (size_t)t * 640 + cc + 8) = pk8(acc[m][2], acc[m][3]);
#pragma unroll
                        for (int n = 0; n < 4; ++n)
                            ssq[m] += acc[m][n][0] * acc[m][n][0] + acc[m][n][1] * acc[m][n][1] + acc[m][n][2] * acc[m][n][2] + acc[m][n][3] * acc[m][n][3]; }
                } } }
        const float tot = tile_row_reduce(lds + LDS_RED, ssq);
        if (tid < nvalid) { const int t = t0 + tid;
            if (nt == 0) RSTDC[t] = rsqrtf(tot * (1.f / KVLR) + EPS);
            else if (t < NREAL) SSQQ[2 * t + (nt - 1)] = tot; }
    }
}

DEV void phase_comb_latent(char* lds, const Args& a, bool dry = false) {
    const bf16_t* HB = (const bf16_t*)(a.ws + WS_A); const bf16_t* WCAT = (const bf16_t*)(a.ws + WS_WCAT);
    auto koff = [](int kc) { return kc * 64; };
    for (int u = blockIdx.x; u < 256; u += gridDim.x) {
        combine_unit(lds, a, u * 128, 128, dry);
        __syncthreads();
        const int t0 = u * 128;
        auto arow = [&](int r) { return HB + (size_t)(t0 + r) * D; };
        GtPtrs P = gt_ptrs(arow, [&](int c) { return WCAT + (size_t)pcol(c) * 1024; });
        gt_issue2(lds, P, 16, koff);
        GtPtrs P1, P2;
        { int u0 = u; asm volatile("" : "+s"(u0));
          latent_tile<0>(lds, a, u0, P, false, [&]() { P1 = gt_ptrs(arow, [&](int c) { return WCAT + (size_t)(256 + (c < 64 ? rcol(c) : pcol(c))) * 1024; }); gt_issue2(lds, P1, 16, koff); }); }
        { int u1 = u; asm volatile("" : "+s"(u1));
          latent_tile<1>(lds, a, u1, P1, true, [&]() { P2 = gt_ptrs(arow, [&](int c) { return WCAT + (size_t)(512 + pcol(c)) * 1024; }); gt_issue2(lds, P2, 16, koff); }); }
        { int u2 = u; asm volatile("" : "+s"(u2)); latent_tile<2>(lds, a, u2, P2, true, [&]() {}); }
    }
    for (int j = blockIdx.x; j < 2; j += gridDim.x) {
        __syncthreads();
        combine_unit(lds, a, NREAL, 16, dry, false);
        __syncthreads();
        auto arow = [&](int r) { return HB + (size_t)(NREAL + (r < 16 ? r : 0)) * D; };
        if (j == 0) { const GtPtrs P = gt_ptrs(arow, [&](int c) { return WCAT + (size_t)pcol(c) * 1024; }); gt_issue2(lds, P, 16, koff);
            int u0 = 256; asm volatile("" : "+s"(u0)); latent_tile<0>(lds, a, u0, P, false, [&]() {}); }
        else { const GtPtrs P = gt_ptrs(arow, [&](int c) { return WCAT + (size_t)(256 + (c < 64 ? rcol(c) : pcol(c))) * 1024; }); gt_issue2(lds, P, 16, koff);
            int u1 = 256; asm volatile("" : "+s"(u1)); latent_tile<1>(lds, a, u1, P, false, [&]() {}); }
    }
}

struct UpSchedKV { const bf16_t* A; const bf16_t* Bt;
    DEV bool next(int i, pg8::Unit& u) const { if (i >= 4) return false; const int L = 4 * (int)blockIdx.x + i; if (L >= 1024) return false; u.pm = L >> 3; u.pn = L & 7; return true; }
    DEV const char* a_base(const pg8::Unit& u) const { return (const char*)(A + (size_t)u.pm * 256 * 640); }
    DEV const char* b_base(const pg8::Unit& u) const { return (const char*)(Bt + (size_t)u.pn * 256 * 256); }
    DEV unsigned a_off(const pg8::Unit&, int h, int R) const { return (unsigned)((128 * h + R) * 640); }
    DEV int b_row(const pg8::Unit&, int, int R) const { return (R & ~31) + pg8::perm32(R & 31); } };
struct UpEpiKV { const Args* a;
    DEV void operator()(const f32x4 (&acc)[2][2][4][2], const pg8::Unit& u, int wr, int wc, int fr, int fq) const {
        const float* RSTDC = (const float*)(a->ws + WS_RSTDC); bf16_t* dst = (bf16_t*)(a->ws + (u.pn < 4 ? WS_D : WS_A));
#pragma unroll
        for (int ai = 0; ai < 2; ++ai)
#pragma unroll
            for (int m = 0; m < 4; ++m) { const int t = u.pm * 256 + ai * 128 + wr * 64 + m * 16 + fr; const float rs = RSTDC[t];
                bf16_t* o = dst + ((size_t)(t >> 12) * LP + NMETA + (t & (SEQ - 1))) * 1024 + (u.pn & 3) * 256 + wc * 32 + fq * 8;
#pragma unroll
                for (int bj = 0; bj < 2; ++bj) *(u32x4*)(o + bj * 128) = pk8(acc[ai][bj][m][0] * rs, acc[ai][bj][m][1] * rs); }
    } };
struct UpSchedQ { const bf16_t* A; const bf16_t* Bt;
    DEV bool next(int i, pg8::Unit& u) const { if (i >= 3) return false; const int L = 3 * (int)blockIdx.x + i; if (L >= 768) return false; u.pm = L / 6; u.pn = L % 6; return true; }
    DEV const char* a_base(const pg8::Unit& u) const { return (const char*)(A + (size_t)u.pm * 256 * 640 + 256); }
    DEV const char* b_base(const pg8::Unit& u) const { return (const char*)(Bt + (size_t)u.pn * 256 * 384); }
    DEV unsigned a_off(const pg8::Unit&, int h, int R) const { return (unsigned)((128 * h + R) * 640); }
    DEV int b_row(const pg8::Unit& u, int h, int R) const {
        if ((u.pn * 4 + h * 2 + (R >> 6)) % 3 == 2) { const int r6 = R & 63, g = r6 >> 5, n = (r6 >> 4) & 1, i = r6 & 15; return (R & 64) + n * 32 + g * 16 + i; }
        return (R & ~31) + pg8::perm32(R & 31); } };
struct UpEpiQ { const Args* a;
    DEV void operator()(const f32x4 (&acc)[2][2][4][2], const pg8::Unit& u, int wr, int wc, int fr, int fq) const {
        const float* SSQQ = (const float*)(a->ws + WS_SSQQ); bf16_t* Q = (bf16_t*)(a->ws + WS_B);
        const float* COS = (const float*)(a->ws + WS_COS); const float* SIN = (const float*)(a->ws + WS_SIN);
#pragma unroll
        for (int ai = 0; ai < 2; ++ai)
#pragma unroll
            for (int m = 0; m < 4; ++m) { const int t = u.pm * 256 + ai * 128 + wr * 64 + m * 16 + fr;
                const float rs = rsqrtf((SSQQ[2 * t] + SSQQ[2 * t + 1]) * (1.f / QLR) + EPS);
                bf16_t* qrow = Q + (size_t)t * 1536 + u.pn * 256;
#pragma unroll
                for (int bj = 0; bj < 2; ++bj) {
                    if ((u.pn * 4 + bj * 2 + (wc >> 1)) % 3 == 2) {
                        const int p = NMETA + (t & (SEQ - 1)), i0 = (wc & 1) * 16 + fq * 4;
                        const f32x4 cs = *(const f32x4*)(COS + p * 32 + i0), sn = *(const f32x4*)(SIN + p * 32 + i0);
                        const f32x4 x1 = acc[ai][bj][m][0] * rs, x2 = acc[ai][bj][m][1] * rs;
                        const f32x4 o1 = x1 * cs - x2 * sn, o2 = x1 * sn + x2 * cs;
                        bf16_t* o = qrow + bj * 128 + (wc >> 1) * 64 + i0;
                        *(u32x2*)o = u32x2{pk2(o1[0], o1[1]), pk2(o1[2], o1[3])}; *(u32x2*)(o + 32) = u32x2{pk2(o2[0], o2[1]), pk2(o2[2], o2[3])};
                    } else *(u32x4*)(qrow + bj * 128 + wc * 32 + fq * 8) = pk8(acc[ai][bj][m][0] * rs, acc[ai][bj][m][1] * rs);
                } }
    } };
DEV void phase_up(char* lds, const Args& a) {
    const int tid = otid(), lane = tid & 63, wid = tid >> 6, wr = wid >> 2, wc = wid & 3, fr = lane & 15, fq = lane >> 4;
    const bf16_t* CRAW = (const bf16_t*)(a.ws + WS_C); const bf16_t* WUKV = (const bf16_t*)(a.ws + WS_WUKV); const bf16_t* WUQ = (const bf16_t*)(a.ws + WS_WUQ);
    const float* RSTDC = (const float*)(a.ws + WS_RSTDC);
    bf16_t* KN = (bf16_t*)(a.ws + WS_D); bf16_t* V = (bf16_t*)(a.ws + WS_A);
    { const int gt = blockIdx.x * NTHR + tid, GT = gridDim.x * NTHR;
      for (int i = gt; i < NB * 48 * 128; i += GT) { const int b = i / (48 * 128), r = i % (48 * 128);
          *(u32x4*)(V + ((size_t)b * LP + 4112) * 1024 + (size_t)r * 8) = u32x4{0u, 0u, 0u, 0u}; } }
    { const UpSchedKV S{CRAW, WUKV}; const UpEpiKV E{&a}; pg8::gemm_phase(lds, 256, S, E); }
    { const UpSchedQ S{CRAW, WUQ}; const UpEpiQ E{&a}; pg8::gemm_phase(lds, 384, S, E); }
    auto koff = [](int kc) { return kc * 64; };
    for (int j = blockIdx.x; j < 8; j += gridDim.x) {
        __syncthreads();
        const int nt = j;
        f32x4 acc[4][4]; zero_acc(acc);
        const GtPtrs P = gt_ptrs([&](int r) { return CRAW + (size_t)(NREAL + (r < 16 ? r : 0)) * 640; }, [&](int c) { return WUKV + (size_t)(nt * 256 + pcol(c)) * 256; });
        gt_issue2(lds, P, 4, koff);
        gt_run<0, 3>(lds, acc, 4, P, koff, false, 16);
        bf16_t* dst = nt < 4 ? KN : V;
        if (wr == 0) { const int r = fr; const float rs = RSTDC[NREAL + r];
            const int colb = (nt & 3) * 256 + wc * 64 + fq * 16;
            const u32x4 w0 = pk8(acc[0][0] * rs, acc[0][1] * rs), w1 = pk8(acc[0][2] * rs, acc[0][3] * rs);
            for (int b = 0; b < NB; ++b) { bf16_t* o = dst + ((size_t)b * LP + r) * 1024 + colb; *(u32x4*)o = w0; *(u32x4*)(o + 8) = w1; } }
    }
}

#if NAIVE_ATTN
DEV void phase_attn(char* lds, const Args& a) {
    (void)lds;
    const int tid = threadIdx.x, lane = tid & 63, wid = tid >> 6;
    bf16_t* Q = (bf16_t*)(a.ws + WS_B); const bf16_t* KN = (const bf16_t*)(a.ws + WS_D); const bf16_t* V = (const bf16_t*)(a.ws + WS_A); const bf16_t* KR = (const bf16_t*)(a.ws + WS_KR);
    const int nw = gridDim.x * 8;
    for (int task = blockIdx.x * 8 + wid; task < NB * NH * SEQ; task += nw) {
        const int s = task & (SEQ - 1), bh = task >> 12, b = bh >> 3, h = bh & 7;
        const int t = b * SEQ + s;
        bf16_t* q = Q + (size_t)t * 1536 + h * 192;
        const float q0 = bf2f(q[lane]), q1 = bf2f(q[lane + 64]), q2 = bf2f(q[128 + lane]);
        float mx = -1e30f, l = 0.f, o0 = 0.f, o1 = 0.f;
        const int nkeys = NMETA + s + 1;
        for (int j = 0; j < nkeys; ++j) {
            const size_t kr = (size_t)b * LP + j;
            const bf16_t* kn = KN + kr * 1024 + h * 128; const bf16_t* kp = KR + kr * 64; const bf16_t* vp = V + kr * 1024 + h * 128;
            float sc = q0 * bf2f(kn[lane]) + q1 * bf2f(kn[lane + 64]) + q2 * bf2f(kp[lane]);
            sc = wave_sum(sc) * ATTN_SCALE;
            const float mn = fmaxf(mx, sc), al = __expf(mx - mn), p = __expf(sc - mn);
            l = l * al + p; o0 = o0 * al + p * bf2f(vp[lane]); o1 = o1 * al + p * bf2f(vp[lane + 64]); mx = mn;
        }
        const float il = 1.f / l;
        const unsigned w0 = pk2(o0 * il, 0.f), w1 = pk2(o1 * il, 0.f);
        q[lane] = (bf16_t)(w0 & 0xffff); q[lane + 64] = (bf16_t)(w1 & 0xffff);
    }
}
#endif


#if !NAIVE_ATTN
namespace att {
typedef short s16x4 __attribute__((ext_vector_type(4)));
typedef float f32x16 __attribute__((ext_vector_type(16)));
constexpr int NW = 8, QBLK = 32, KVBLK = 64, QB = 256;
constexpr int SHM_V = 64 * 128 * 2, SHM_K = 64 * 192 * 2;
constexpr int QS = 1536, KNS = 1024, KRS = 64, VS = 1024, OS = 1536;
constexpr float THR = 8.f;
constexpr float SCALE = ATTN_SCALE;
constexpr int NQB = SEQ / QB;
#ifndef ATT_NQR
#define ATT_NQR 5
#endif
constexpr int NQR = ATT_NQR;
constexpr int Q_LDS = 2 * SHM_V + 2 * SHM_K + 2048;
#define KSWZ(row, colB) ((row) * 384 + ((colB) ^ ((((row) >> 1) & 7) << 4)))
#define SBAR() __builtin_amdgcn_sched_barrier(0)
DEV int v_st(int k, int c) { const int kk = (k & ~0xC) | ((k & 4) << 1) | ((k & 8) >> 1); return ((kk >> 3) * 4 + (c >> 5)) * 512 + ((kk & 7) * 32 + (c & 31)) * 2; }
DEV int v_rd_base(int lane) { return ((lane & 3) << 3) | (((lane >> 2) & 3) << 6) | (((lane >> 4) & 1) << 5) | (((lane >> 5) & 1) << 8); }
constexpr int v_rd_off(int d0, int ks, int half) { return d0 * 512 + ks * 4096 + half * 2048; }
DEV int crow(int r, int hi) { return (r & 3) + 8 * (r >> 2) + 4 * hi; }
DEV unsigned cvtpk(float lo, float hi) { unsigned r; asm volatile("v_cvt_pk_bf16_f32 %0, %1, %2" : "=v"(r) : "v"(lo), "v"(hi)); return r; }
DEV void mask_tile(f32x16& p0, f32x16& p1, int dq) {
    const float NEG = -__builtin_inff();
#pragma unroll
    for (int r = 0; r < 16; ++r) {
        const int c = (r & 3) + 8 * (r >> 2);
        if (dq - c < 0) p0[r] = NEG;
        if (dq - c - 32 < 0) p1[r] = NEG;
    }
}
DEV void partialSM(f32x16& p0, f32x16& p1, float& m_reg, float& mn, float& alpha) {
    float pmax = p0[0];
#pragma unroll
    for (int r = 1; r < 16; ++r) pmax = fmaxf(pmax, p0[r]);
#pragma unroll
    for (int r = 0; r < 16; ++r) pmax = fmaxf(pmax, p1[r]);
    { auto rr = __builtin_amdgcn_permlane32_swap(__float_as_uint(pmax), __float_as_uint(pmax), false, false);
      pmax = fmaxf(__uint_as_float(rr[0]), __uint_as_float(rr[1])); }
    constexpr float C2 = 1.4426950408889634f * SCALE;
    if (__builtin_expect(__all((pmax - m_reg) * SCALE <= THR), 1)) { mn = m_reg; alpha = 1.f; }
    else { mn = fmaxf(m_reg, pmax); alpha = __builtin_amdgcn_exp2f((m_reg - mn) * C2); m_reg = mn; }
    const float mnL = -mn * C2;
#pragma unroll
    for (int r = 0; r < 16; ++r) p0[r] = fmaf(p0[r], C2, mnL);
#pragma unroll
    for (int r = 0; r < 16; ++r) p1[r] = fmaf(p1[r], C2, mnL);
#pragma unroll
    for (int r = 0; r < 16; ++r) p0[r] = __builtin_amdgcn_exp2f(p0[r]);
}
DEV void finishSM(f32x16& p0, f32x16& p1, float alpha, float& l_reg, bf16x8& pa0, bf16x8& pa1, bf16x8& pa2, bf16x8& pa3) {
#pragma unroll
    for (int r = 0; r < 16; ++r) p1[r] = __builtin_amdgcn_exp2f(p1[r]);
    float ps = 0;
#pragma unroll
    for (int r = 0; r < 16; ++r) ps += p0[r];
#pragma unroll
    for (int r = 0; r < 16; ++r) ps += p1[r];
    { auto rr = __builtin_amdgcn_permlane32_swap(__float_as_uint(ps), __float_as_uint(ps), false, false);
      ps = __uint_as_float(rr[0]) + __uint_as_float(rr[1]); }
    l_reg = l_reg * alpha + ps;
#define PK4(P, B_, OUT) do { unsigned a0 = cvtpk(P[B_+0], P[B_+1]), a1 = cvtpk(P[B_+2], P[B_+3]);                          \
        unsigned b0 = cvtpk(P[B_+4], P[B_+5]), b1 = cvtpk(P[B_+6], P[B_+7]);                                             \
        auto r0 = __builtin_amdgcn_permlane32_swap(a0, b0, false, false); auto r1 = __builtin_amdgcn_permlane32_swap(a1, b1, false, false); \
        u32x4 w = {r0[0], r1[0], r0[1], r1[1]}; OUT = *reinterpret_cast<bf16x8*>(&w); } while (0)
    PK4(p0, 0, pa0); PK4(p0, 8, pa1); PK4(p1, 0, pa2); PK4(p1, 8, pa3);
#undef PK4
}
template <int KB>
DEV void qkt(f32x16& p0, f32x16& p1, const char* K_lds, int r32, int hi, const bf16x8* qr, const char* qlds) {
    p0 = f32x16{}; p1 = f32x16{};
    const char* kb[4];
#pragma unroll
    for (int dd = 0; dd < 4; ++dd) kb[dd] = K_lds + KB * SHM_K + KSWZ(r32, (dd * 16 + hi * 8) * 2);
#pragma unroll
    for (int d0 = 0; d0 < 12; ++d0) { const char* a = kb[d0 & 3] + (d0 >> 2) * 128;
        bf16x8 b0 = *reinterpret_cast<const bf16x8*>(a);
        bf16x8 b1 = *reinterpret_cast<const bf16x8*>(a + 32 * 384);
        bf16x8 q;
        if (d0 < NQR) q = qr[d0 < NQR ? d0 : 0]; else q = *reinterpret_cast<const bf16x8*>(qlds + (d0 - NQR) * 1024);
        p0 = __builtin_amdgcn_mfma_f32_32x32x16_bf16(b0, q, p0, 0, 0, 0);
        p1 = __builtin_amdgcn_mfma_f32_32x32x16_bf16(b1, q, p1, 0, 0, 0); }
}
template <int VB>
DEV void pv_tile(f32x16* o, int vb0, bf16x8 pa0, bf16x8 pa1, bf16x8 pa2, bf16x8 pa3) {
#define TRRD(dst, off) asm volatile("ds_read_b64_tr_b16 %0, %1 offset:%2" : "=&v"(dst) : "v"(vb0), "i"(off) : "memory")
#define PV_D0(d0) do { s16x4 l0, l1, l2, l3, h0, h1, h2, h3; constexpr int b_ = VB * SHM_V + v_rd_off(d0, 0, 0); \
        TRRD(l0, b_); TRRD(h0, b_ + 2048); TRRD(l1, b_ + 4096); TRRD(h1, b_ + 6144); TRRD(l2, b_ + 8192); TRRD(h2, b_ + 10240); TRRD(l3, b_ + 12288); TRRD(h3, b_ + 14336); \
        asm volatile("s_waitcnt lgkmcnt(0)" ::: "memory"); SBAR();   \
        o[d0] = __builtin_amdgcn_mfma_f32_32x32x16_bf16(pa0, (bf16x8){l0[0], l0[1], l0[2], l0[3], h0[0], h0[1], h0[2], h0[3]}, o[d0], 0, 0, 0);   \
        o[d0] = __builtin_amdgcn_mfma_f32_32x32x16_bf16(pa1, (bf16x8){l1[0], l1[1], l1[2], l1[3], h1[0], h1[1], h1[2], h1[3]}, o[d0], 0, 0, 0);   \
        o[d0] = __builtin_amdgcn_mfma_f32_32x32x16_bf16(pa2, (bf16x8){l2[0], l2[1], l2[2], l2[3], h2[0], h2[1], h2[2], h2[3]}, o[d0], 0, 0, 0);   \
        o[d0] = __builtin_amdgcn_mfma_f32_32x32x16_bf16(pa3, (bf16x8){l3[0], l3[1], l3[2], l3[3], h3[0], h3[1], h3[2], h3[3]}, o[d0], 0, 0, 0); } while (0)
    PV_D0(0); PV_D0(1); PV_D0(2); PV_D0(3);
#undef PV_D0
#undef TRRD
}
struct BlockRef { const bf16_t* Q; const bf16_t* Kn; const bf16_t* Kr; const bf16_t* V; bf16_t* O; int P0; };
struct Seam { bf16x8 qr[NQR]; bf16x8 st0, st1, st2; };
#define VMW() asm volatile("s_waitcnt vmcnt(0)" ::: "memory")
#define SLOAD_K(R, k0) do { const bf16_t* kn_ = (R).Kn + (size_t)(k0) * KNS; const bf16_t* kr2_ = (R).Kr + (size_t)(k0) * KRS; \
        S.st0 = *(const bf16x8*)(kn_ + offKn); S.st1 = *(const bf16x8*)(kn_ + offKn + 64); S.st2 = *(const bf16x8*)(kr2_ + offKr); } while (0)
#define SLOAD_V(R, k0) do { const bf16_t* vb_ = (R).V + (size_t)(k0) * VS; S.st0 = *(const bf16x8*)(vb_ + offV); S.st1 = *(const bf16x8*)(vb_ + offV + 32 * VS); } while (0)
#define SWRITE_K(bf) do { *(bf16x8*)(K_lds + (bf) * SHM_K + kws) = S.st0; *(bf16x8*)(K_lds + (bf) * SHM_K + kws + 128) = S.st1; *(bf16x8*)(K_lds + (bf) * SHM_K + kws + 256) = S.st2; } while (0)
#define SWRITE_V(bf) do { *(bf16x8*)(V_lds + (bf) * SHM_V + vst0) = S.st0; *(bf16x8*)(V_lds + (bf) * SHM_V + vst1) = S.st1; } while (0)
DEV void prime(const BlockRef& cur, char* lds, Seam& S) {
    const int tid = threadIdx.x;
    const int sr = tid >> 4, sc = (tid & 15) * 8, kr_ = tid >> 3, kc8 = (tid & 7) * 8, kws = KSWZ(kr_, kc8 * 2); char* K_lds = lds + 2 * SHM_V;
    const unsigned offV = sr * VS + sc, offKn = kr_ * KNS + kc8, offKr = kr_ * KRS + kc8;
    SLOAD_K(cur, 0); VMW(); SWRITE_K(0); SBAR(); SLOAD_V(cur, 0);
    __syncthreads();
}
DEV void block(const BlockRef& cur, const BlockRef& nxt, char* lds, Seam& S) {
    const int tid = threadIdx.x, wid = __builtin_amdgcn_readfirstlane(tid >> 6), lane = tid & 63, r32 = lane & 31, hi = lane >> 5;
    const int NT = (cur.P0 + QB - 1) / KVBLK + 1;
    const int qlo = cur.P0 + wid * QBLK, qm = qlo + r32 - 4 * hi;
    char* V_lds = lds; char* K_lds = lds + 2 * SHM_V;
    float* ws = (float*)(lds + 2 * SHM_V + 2 * SHM_K) + wid * 64; float* li_l = ws, * al_l = ws + 32;
    float m_reg = -1e30f, l_reg = 0; f32x16 o[4] = {};
    const int sr = tid >> 4, sc = (tid & 15) * 8, vst0 = v_st(sr, sc), vst1 = v_st(32 + sr, sc);
    const int kr_ = tid >> 3, kc8 = (tid & 7) * 8, kws = KSWZ(kr_, kc8 * 2);
    const unsigned offV = sr * VS + sc, offKn = kr_ * KNS + kc8, offKr = kr_ * KRS + kc8;
    const int vb0 = (int)(uintptr_t)V_lds + v_rd_base(lane);
#define RESC(a) do { if (__any((a) < 1.f)) { if (hi == 0) al_l[r32] = (a); asm volatile("s_waitcnt lgkmcnt(0)" ::: "memory");              \
                     for (int d_ = 0; d_ < 4; ++d_) for (int r = 0; r < 16; ++r) o[d_][r] *= al_l[crow(r, hi)]; } } while (0)
#define KBASE(t) ((t) * KVBLK)
#define MASKT(P0_, P1_, t) do { const int kb_ = KBASE(t); if (kb_ + KVBLK - 1 > qlo) mask_tile(P0_, P1_, qm - kb_); } while (0)
    f32x16 pA0, pA1, pB0, pB1; float mnA, mnB, alA, alB; bf16x8 pa0, pa1, pa2, pa3;
    char* qlds = lds + Q_LDS + wid * ((12 - NQR) * 1024) + lane * 16;
    VMW(); SWRITE_V(0); SBAR();
    { const bf16_t* qrow = cur.Q + (size_t)(wid * QBLK + r32) * QS + hi * 8;
#pragma unroll
      for (int d0 = 0; d0 < NQR; ++d0) S.qr[d0] = *(const bf16x8*)(qrow + d0 * 16);
#pragma unroll
      for (int d0 = NQR; d0 < 12; ++d0) { const bf16x8 tq = *(const bf16x8*)(qrow + d0 * 16); *(bf16x8*)(qlds + (d0 - NQR) * 1024) = tq; } }
    SBAR();
    SLOAD_K(cur, KBASE(1));
    SBAR(); qkt<0>(pA0, pA1, K_lds, r32, hi, S.qr, qlds);
    VMW(); SWRITE_K(1); SBAR(); SLOAD_V(cur, KBASE(1));
    MASKT(pA0, pA1, 0); partialSM(pA0, pA1, m_reg, mnA, alA);
    VMW(); SWRITE_V(1); SBAR(); SLOAD_K(cur, KBASE(2));
    __syncthreads();
#define HALF_STEP(PX0, PX1, mnX, alX, PY0, PY1, alY, t, KB, VB, SB) do {                                                      \
        SBAR(); qkt<KB>(PX0, PX1, K_lds, r32, hi, S.qr, qlds);                                                                \
        finishSM(PY0, PY1, alY, l_reg, pa0, pa1, pa2, pa3); SBAR();                                                           \
        if ((t) + 1 < NT) { VMW(); SWRITE_K(SB); SBAR(); SLOAD_V(cur, KBASE((t) + 1)); } SBAR();                              \
        pv_tile<VB>(o, vb0, pa0, pa1, pa2, pa3); MASKT(PX0, PX1, (t)); partialSM(PX0, PX1, m_reg, mnX, alX);                  \
        __syncthreads();                                                                                                      \
        if ((t) + 1 < NT) { VMW(); SWRITE_V(SB); SBAR(); if ((t) + 2 < NT) SLOAD_K(cur, KBASE((t) + 2)); }                    \
        RESC(alX); __syncthreads(); } while (0)
    for (int t = 1; t + 1 < NT; t += 2) {
        HALF_STEP(pB0, pB1, mnB, alB, pA0, pA1, alA, t, 1, 0, 0);
        HALF_STEP(pA0, pA1, mnA, alA, pB0, pB1, alB, t + 1, 0, 1, 1);
    }
    const bool even = (NT & 1) == 0;
    if (even) { SBAR(); qkt<1>(pB0, pB1, K_lds, r32, hi, S.qr, qlds); SBAR(); }
    SLOAD_K(nxt, 0); SBAR();
    finishSM(pA0, pA1, alA, l_reg, pa0, pa1, pa2, pa3); SBAR();
    pv_tile<0>(o, vb0, pa0, pa1, pa2, pa3);
    if (even) { MASKT(pB0, pB1, NT - 1); partialSM(pB0, pB1, m_reg, mnB, alB); __syncthreads(); RESC(alB);
        finishSM(pB0, pB1, alB, l_reg, pa0, pa1, pa2, pa3); SBAR(); pv_tile<1>(o, vb0, pa0, pa1, pa2, pa3); }
    SBAR(); VMW(); SWRITE_K(0); SBAR(); SLOAD_V(nxt, 0); SBAR();
    if (hi == 0) li_l[r32] = l_reg; asm volatile("s_waitcnt lgkmcnt(0)" ::: "memory");
    float rli[16];
#pragma unroll
    for (int r = 0; r < 16; ++r) rli[r] = __builtin_amdgcn_rcpf(li_l[crow(r, hi)]);
    bf16_t* Ow = cur.O + (size_t)(wid * QBLK) * OS;
#pragma unroll
    for (int r = 0; r < 16; ++r) { const int orow = crow(r, hi);
#pragma unroll
        for (int d0 = 0; d0 < 4; ++d0) { const float v = o[d0][r] * rli[r];
            const float vn = __shfl_xor(v, 1);
            if ((r32 & 1) == 0) *(unsigned*)(Ow + (size_t)orow * OS + d0 * 32 + r32) = cvtpk(v, vn); } }
    __syncthreads();
#undef RESC
#undef KBASE
#undef MASKT
#undef HALF_STEP
}
#undef VMW
#undef SLOAD_K
#undef SLOAD_V
#undef SWRITE_K
#undef SWRITE_V
}
DEV att::BlockRef attn_ref(const Args& a, int bh, int qb) {
    const int b = bh >> 3, h = bh & 7;
    att::BlockRef r;
    bf16_t* Q = (bf16_t*)(a.ws + WS_B);
    r.Q = Q + ((size_t)b * SEQ + (size_t)qb * 256) * 1536 + h * 192; r.O = Q + ((size_t)b * SEQ + (size_t)qb * 256) * 1536 + h * 192;
    r.Kn = (const bf16_t*)(a.ws + WS_D) + (size_t)b * LP * 1024 + h * 128; r.Kr = (const bf16_t*)(a.ws + WS_KR) + (size_t)b * LP * 64;
    r.V = (const bf16_t*)(a.ws + WS_A) + (size_t)b * LP * 1024 + h * 128; r.P0 = NMETA + qb * 256;
    return r;
}
DEV void phase_attn(char* lds, const Args& a) {
    const int total = NB * NH * 8, stride = gridDim.x;
    int L = vbid(); if (L >= total) return;
    int pass = 0;
    att::BlockRef cur = attn_ref(a, L >> 3, L & 7);
    att::Seam S;
    att::prime(cur, lds, S);
    for (;;) {
        const bool more_pass = pass == 0, more_item = L + stride < total, last = !more_pass && !more_item;
        int passn = pass + 1, Ln = L;
        if (!more_pass) { passn = 0; Ln = more_item ? L + stride : L; }
        const int yn = Ln & 7;
        const att::BlockRef nxt = last ? cur : attn_ref(a, Ln >> 3, passn ? 15 - yn : yn);
        att::block(cur, nxt, lds, S);
        if (last) break;
        cur = nxt; pass = passn; L = Ln;
    }
}
#endif

DEV void phase_wo_router(char* lds, const Args& a, bool dry = false) {
    const int tid = otid(), lane = tid & 63, wid = tid >> 6, wr = wid >> 2, wc = wid & 3, fr = lane & 15, fq = lane >> 4;
    const bf16_t* O = (const bf16_t*)(a.ws + WS_B); const bf16_t* WOT = (const bf16_t*)(a.ws + WS_WO);
    float* H = (float*)(a.ws + WS_H); bf16_t* HB = (bf16_t*)(a.ws + WS_A); float* RSTD = (float*)(a.ws + WS_RSTD);
    for (int u = blockIdx.x; u < 256; u += gridDim.x) {
        const int t0 = u * 128;
        float ssq[4] = {0.f, 0.f, 0.f, 0.f};
        f32x4 racc[4][3];
#pragma unroll
        for (int m = 0; m < 4; ++m)
#pragma unroll
            for (int n = 0; n < 3; ++n) racc[m][n] = f32x4{0.f, 0.f, 0.f, 0.f};
        const bf16_t* WH = (const bf16_t*)(a.ws + WS_WRT) + 98304; const bf16_t* WL = WH + 49152;
        auto koff = [](int kc) { return (kc >> 1) * 192 + (kc & 1) * 64; };
        auto arow = [&](int r) { return O + (size_t)(t0 + r) * 1536; };
        GtPtrs P = gt_ptrs(arow, [&](int c) { return WOT + (size_t)pcol(c) * 1024; });
        gt_issue2(lds, P, 16, koff);
        bool pre = false;
#pragma unroll 1
        for (int nt = 0; nt < 4; ++nt) {
            f32x4 acc[4][4]; zero_acc(acc);
            gt_run<16>(lds, acc, 16, P, koff, pre);
            f32x4 hh[4][4];
#pragma unroll
            for (int m = 0; m < 4; ++m) { const float* hr = H + (size_t)(t0 + wr * 64 + m * 16 + fr) * D + nt * 256 + wc * 64 + fq * 16;
#pragma unroll
                for (int n = 0; n < 4; ++n) hh[m][n] = *(const f32x4*)(hr + n * 4); }
            const float sc = dry ? 0.f : 1.f;
#pragma unroll
            for (int m = 0; m < 4; ++m)
#pragma unroll
                for (int n = 0; n < 4; ++n) hh[m][n] += acc[m][n] * sc;
            router_acc(racc, hh, WH, WL, nt * 256 + wc * 64, fr, fq);
#pragma unroll
            for (int m = 0; m < 4; ++m)
#pragma unroll
                for (int n = 0; n < 3; ++n) asm volatile("" : "+v"(racc[m][n]));
            if (nt < 3) { const int n1 = nt + 1; P = gt_ptrs(arow, [&](int c) { return WOT + (size_t)(n1 * 256 + pcol(c)) * 1024; }); gt_issue2(lds, P, 16, koff); }
            pre = true;
#pragma unroll
            for (int m = 0; m < 4; ++m) { const int t = t0 + wr * 64 + m * 16 + fr;
                const int col0 = nt * 256 + wc * 64 + fq * 16;
#pragma unroll
                for (int n = 0; n < 4; ++n) { const f32x4 h = hh[m][n];
                    *(f32x4*)(H + (size_t)t * D + col0 + n * 4) = h;
                    ssq[m] += h[0] * h[0] + h[1] * h[1] + h[2] * h[2] + h[3] * h[3]; }
                *(u32x4*)(HB + (size_t)t * D + col0) = pk8(hh[m][0], hh[m][1]); *(u32x4*)(HB + (size_t)t * D + col0 + 8) = pk8(hh[m][2], hh[m][3]); }
        }
        const float tot = tile_row_reduce(lds + LDS_RED, ssq);
        if (tid < 128) RSTD[t0 + tid] = rsqrtf(tot * (1.f / D) + EPS);
        router_part_store(lds, racc, wr, wc, fr, fq);
        __syncthreads();
        router_decide(lds, a, 1, t0, 128, dry);
    }
}

DEV void phase_final(const Args& a) {
    const int tid = otid(), lane = tid & 63, wid = tid >> 6;
    const float* H = (const float*)(a.ws + WS_H); const bf16_t* Y = (const bf16_t*)(a.ws + WS_B);
    for (int t = blockIdx.x * 8 + wid; t < NREAL; t += gridDim.x * 8) {
        f32x4 h[4]; float s = 0.f;
#pragma unroll
        for (int q = 0; q < 4; ++q) { const int col = q * 256 + lane * 4;
            h[q] = *(const f32x4*)(H + (size_t)t * D + col);
            const u32x2 y0 = *(const u32x2*)(Y + (size_t)(2 * t) * D + col), y1 = *(const u32x2*)(Y + (size_t)(2 * t + 1) * D + col);
            h[q][0] += bflo(y0[0]) + bflo(y1[0]); h[q][1] += bfhi(y0[0]) + bfhi(y1[0]); h[q][2] += bflo(y0[1]) + bflo(y1[1]); h[q][3] += bfhi(y0[1]) + bfhi(y1[1]);
            s += h[q][0] * h[q][0] + h[q][1] * h[q][1] + h[q][2] * h[q][2] + h[q][3] * h[q][3]; }
        s = wave_sum(s);
        const float rs = rsqrtf(s * (1.f / D) + EPS);
#pragma unroll
        for (int q = 0; q < 4; ++q) { const int col = q * 256 + lane * 4;
            const f32x4 g = *(const f32x4*)(a.final_norm + col);
            *(f32x4*)(a.out + (size_t)t * D + col) = h[q] * rs * g; }
    }
}


__global__ void __launch_bounds__(NTHR, 2) fwd(Args a) {
    extern __shared__ __attribute__((aligned(16))) char lds[];
    if (threadIdx.x == 0) *(u32x4*)(lds + LDS_XB) = u32x4{0u, 0u, 0u, 0u};
    __syncthreads();
    const bool multi = a.ph_hi - a.ph_lo > 1;
    XcdBarrier bar; bar.bar = (unsigned*)(a.ws + WS_CTL); bar.x = 0; bar.st = (volatile LAS unsigned*)(lds + LDS_XB);
    if (multi) bar = xcd_barrier_post((unsigned*)(a.ws + WS_CTL), (volatile LAS unsigned*)(lds + LDS_XB));
#define PHASE(i, call) if (a.ph_lo <= (i) && (i) < a.ph_hi) { if (a.ph_lo < (i)) xcd_barrier(bar); call; }
    PHASE(0, phase_prologue(lds, a))
    PHASE(1, phase_front(lds, a))
    PHASE(2, phase_moe1(lds, a, 0))
    PHASE(3, phase_moe2(lds, a, 0))
    PHASE(4, phase_comb_latent(lds, a))
    PHASE(5, phase_up(lds, a))
    PHASE(6, { phase_attn(lds, a); __syncthreads(); for (int i = blockIdx.x; i < TR_MOE; i += gridDim.x) tr_moe_job(lds, a, 1, i); })
    PHASE(7, phase_wo_router(lds, a))
    PHASE(8, phase_moe1(lds, a, 1))
    PHASE(9, phase_moe2(lds, a, 1))
    PHASE(10, phase_final(a))
#undef PHASE
}

extern "C" void kernel_launch(void* const* d_in, const int* in_sizes, int n_in, void* d_out, int out_size, void* d_ws, size_t ws_size, hipStream_t stream) {
    (void)in_sizes; (void)n_in; (void)out_size;
    static bool once = false;
    if (!once) { once = true;
        hipError_t e = hipFuncSetAttribute((const void*)fwd, hipFuncAttributeMaxDynamicSharedMemorySize, LDS_BYTES);
        if (e != hipSuccess) fprintf(stderr, "hipFuncSetAttribute: %s\n", hipGetErrorString(e));
        if (ws_size < WS_END) fprintf(stderr, "workspace too small: %zu < %zu\n", ws_size, (size_t)WS_END);
    }
    Args a{};
    const float* const* in = (const float* const*)d_in;
    a.x = in[0]; a.meta = in[1]; a.a_norm = in[2]; a.a_w = in[3]; a.a_scale = in[4];
    a.b_norm = in[5]; a.w_dq = in[6]; a.q_norm = in[7]; a.w_uq = in[8]; a.w_o = in[9];
    a.kv_norm = in[10]; a.w_dkv = in[11]; a.kv_lat_norm = in[12]; a.w_uk = in[13]; a.w_uv = in[14];
    a.ffn_norm = in[15]; a.router_g = in[16]; a.router_g_bias = in[17]; a.router_e = in[18]; a.router_e_bias = in[19];
    a.w_gate = in[20]; a.w_up = in[21]; a.w_down = in[22]; a.final_norm = in[23];
    a.out = (float*)d_out; a.ws = (unsigned char*)d_ws;
    (void)hipMemsetAsync(d_ws, 0, CTL_BYTES, stream);
    static int grid = 0;
    if (!grid) { int dev = 0, cus = 0, per_cu = 0;
        (void)hipGetDevice(&dev); (void)hipDeviceGetAttribute(&cus, hipDeviceAttributeMultiprocessorCount, dev);
        (void)hipOccupancyMaxActiveBlocksPerMultiprocessor(&per_cu, (const void*)fwd, NTHR, LDS_BYTES);
        if (cus <= 0) cus = 256;
        if (per_cu < 1) fprintf(stderr, "occupancy query says %d blocks per CU\n", per_cu);
        grid = cus;
    }
#if ONE_LAUNCH
    a.ph_lo = 0; a.ph_hi = NPHASE;
    hipLaunchKernelGGL(fwd, dim3(grid), dim3(NTHR), LDS_BYTES, stream, a);
#else
    for (int p = 0; p < NPHASE; ++p) { a.ph_lo = p; a.ph_hi = p + 1; hipLaunchKernelGGL(fwd, dim3(grid), dim3(NTHR), LDS_BYTES, stream, a); }
#endif
}
```

```cpp
#include <hip/hip_runtime.h>
#include <stdint.h>
#include <stdio.h>

#ifndef NAIVE_GEMM
#define NAIVE_GEMM 0
#endif
#ifndef NAIVE_ATTN
#define NAIVE_ATTN 0
#endif
#ifndef ONE_LAUNCH
#define ONE_LAUNCH 1
#endif

typedef unsigned short bf16_t;
typedef short bf16x8 __attribute__((ext_vector_type(8)));
typedef float f32x4 __attribute__((ext_vector_type(4)));
typedef float f32x2 __attribute__((ext_vector_type(2)));
typedef unsigned u32x4 __attribute__((ext_vector_type(4)));
typedef unsigned u32x2 __attribute__((ext_vector_type(2)));
#define DEV __device__ __forceinline__

constexpr int D = 1024, NB = 8, SEQ = 4096, NREAL = NB * SEQ, NMETA = 16, M1 = NREAL + NMETA;
constexpr int LP = 4160;
constexpr int NH = 8, DQK = 192, DNOPE = 128, DROPE = 64, DV = 128, QLR = 384, KVLR = 256;
constexpr int NE = 32, DE = 256;
constexpr int NSLOT = 2 * M1;
constexpr float EPS = 1e-6f;
constexpr float ATTN_SCALE = 0.07216878364870322f;
constexpr int NTHR = 512;
constexpr int LDS_BYTES = 163840;
constexpr int LDS_XB = LDS_BYTES - 16;
constexpr int NPHASE = 11;

constexpr size_t al256(size_t x) { return (x + 255) & ~(size_t)255; }
constexpr size_t WS_CTL = 0;
constexpr size_t CTL_BYTES = 32768;
constexpr size_t CTL_CNT = 16384;
constexpr size_t WS_LISTS = WS_CTL + CTL_BYTES;
constexpr size_t WS_GATEW = al256(WS_LISTS + (size_t)NE * M1 * 4);
constexpr size_t WS_RSTD = al256(WS_GATEW + (size_t)NSLOT * 4);
constexpr size_t WS_RSTDC = al256(WS_RSTD + (size_t)M1 * 4);
constexpr size_t WS_SSQQ = al256(WS_RSTDC + (size_t)M1 * 4);
constexpr size_t WS_COS = al256(WS_SSQQ + (size_t)NREAL * 8);
constexpr size_t WS_SIN = al256(WS_COS + (size_t)4112 * 32 * 4);
constexpr size_t WS_WR = al256(WS_SIN + (size_t)4112 * 32 * 4);
constexpr size_t WS_BIAS = al256(WS_WR + (size_t)2 * 1024 * 36 * 4);
constexpr size_t WS_WRT = al256(WS_BIAS + 512);
constexpr size_t WS_AWT = al256(WS_WRT + (size_t)2 * 2 * 48 * 1024 * 2);
constexpr size_t WS_WCAT = al256(WS_AWT + (size_t)4 * 256 * 256 * 2);
constexpr size_t WS_WUKV = al256(WS_WCAT + (size_t)768 * 1024 * 2);
constexpr size_t WS_WUQ = al256(WS_WUKV + (size_t)2048 * 256 * 2);
constexpr size_t WS_WO = al256(WS_WUQ + (size_t)1536 * 384 * 2);
constexpr size_t WS_WGU = al256(WS_WO + (size_t)1024 * 1024 * 2);
constexpr size_t WS_WD = al256(WS_WGU + (size_t)NE * 512 * 1024 * 2);
constexpr size_t WS_HB = al256(WS_WD + (size_t)NE * 1024 * 256 * 2);
constexpr size_t WS_HMETA = WS_HB + (size_t)M1 * D * 2;
constexpr size_t WS_A = al256(WS_HMETA + (size_t)2 * 16 * D * 2);
constexpr size_t SZ_A = (size_t)NB * LP * 1024 * 2;
constexpr size_t WS_B = al256(WS_A + SZ_A);
constexpr size_t SZ_B = (size_t)NSLOT * 1024 * 2;
constexpr size_t WS_C = al256(WS_B + SZ_B);
constexpr size_t WS_KR = WS_C + (size_t)M1 * 640 * 2;
constexpr size_t SZ_C = (size_t)M1 * 640 * 2 + (size_t)NB * LP * 64 * 2;
constexpr size_t WS_D = al256(WS_C + SZ_C);
constexpr size_t SZ_D = (size_t)NB * LP * 1024 * 2;
constexpr size_t WS_END = WS_D + SZ_D;
static_assert((size_t)NREAL * 1536 * 2 <= SZ_B, "Q fits in region B");
static_assert((size_t)(NSLOT + 128) * 256 * 2 <= SZ_D, "ACT fits in region D");

struct Args {
    const float* x; const float* meta; const float* a_norm; const float* a_w; const float* a_scale;
    const float* b_norm; const float* w_dq; const float* q_norm; const float* w_uq; const float* w_o;
    const float* kv_norm; const float* w_dkv; const float* kv_lat_norm; const float* w_uk; const float* w_uv;
    const float* ffn_norm; const float* router_g; const float* router_g_bias; const float* router_e; const float* router_e_bias;
    const float* w_gate; const float* w_up; const float* w_down; const float* final_norm;
    float* out; unsigned char* ws; int ph_lo, ph_hi;
};

DEV unsigned pk2(float lo, float hi) {
    typedef __bf16 b2 __attribute__((ext_vector_type(2)));
    f32x2 v = {lo, hi}; b2 b = __builtin_convertvector(v, b2); return __builtin_bit_cast(unsigned, b);
}
DEV float bf2f(unsigned short u) { return __uint_as_float((unsigned)u << 16); }
DEV float bflo(unsigned u) { return __uint_as_float(u << 16); }
DEV float bfhi(unsigned u) { return __uint_as_float(u & 0xffff0000u); }
DEV int otid() { int t = threadIdx.x; asm volatile("" : "+v"(t)); return t; }
DEV float wave_sum(float v) {
#pragma unroll
    for (int o = 32; o >= 1; o >>= 1) v += __shfl_xor(v, o);
    return v;
}
DEV const float* h0_row(const Args& a, int t) { return t < NREAL ? a.x + (size_t)t * D : a.meta + (size_t)(t - NREAL) * D; }
DEV const float* seq_row(const Args& a, int b, int p) { return p < NMETA ? a.meta + (size_t)p * D : a.x + ((size_t)b * SEQ + (p - NMETA)) * D; }

#define XB_TMO      128
#define XB_XCNT(j)  (256  + 64 * (j))
#define XB_XSUB(j)  (1280 + 64 * (j))
#define XB_XGEN(j)  (2304 + 64 * (j))
#define XB_TOP      3328
#define XB_TOPGEN   3392
#define XCD_BAR_WORDS 3456
#define XB_SPIN_CAP (1u << 18)
#define LAS __attribute__((address_space(3)))

__device__ __forceinline__ unsigned xb_ld(unsigned* p)              { return __hip_atomic_load(p, __ATOMIC_RELAXED, __HIP_MEMORY_SCOPE_AGENT); }
__device__ __forceinline__ unsigned xb_add(unsigned* p, unsigned v) { return __hip_atomic_fetch_add(p, v, __ATOMIC_RELAXED, __HIP_MEMORY_SCOPE_AGENT); }
__device__ __forceinline__ unsigned xb_xcc_id() { return (unsigned)__builtin_amdgcn_s_getreg((3 << 11) | 20) & 0xFu; }
#define XB_SPIN(cond, bar) do { unsigned _sp = 0; while (cond) { __builtin_amdgcn_s_sleep(1); \
    if ((++_sp & 255u) == 0u) { if (xb_ld(&(bar)[XB_TMO])) break; if (_sp > XB_SPIN_CAP) { atomicAdd(&(bar)[XB_TMO], 1u); break; } } } } while (0)

struct XcdBarrier { unsigned* bar; unsigned x; volatile LAS unsigned* st; };

__device__ __forceinline__ XcdBarrier xcd_barrier_post(unsigned* bar, volatile LAS unsigned* st) {
    XcdBarrier b; b.bar = bar; b.x = xb_xcc_id(); b.st = st;
    if (threadIdx.x == 0) (void)xb_add(&bar[XB_XCNT(b.x)], 1u);
    return b;
}
__device__ __forceinline__ void xcd_barrier_complete(unsigned* bar, unsigned x, unsigned& nloc, unsigned& nx) {
    const unsigned G = gridDim.x * gridDim.y * gridDim.z;
    unsigned sum, cnt, mine, sp = 0u;
    for (;;) {
        sum = 0u; cnt = 0u; mine = 0u;
#pragma unroll
        for (unsigned j = 0; j < 16; ++j) { const unsigned c = xb_ld(&bar[XB_XCNT(j)]); sum += c; cnt += (c > 0u) ? 1u : 0u; mine = (j == x) ? c : mine; }
        if (sum == G) break;
        __builtin_amdgcn_s_sleep(1);
        if ((++sp & 255u) == 0u) { if (xb_ld(&bar[XB_TMO])) break; if (sp > XB_SPIN_CAP) { atomicAdd(&bar[XB_TMO], 1u); break; } }
    }
    nloc = mine > 0u ? mine : 1u; nx = cnt > 0u ? cnt : 1u;
}
__device__ __forceinline__ void xcd_barrier(const XcdBarrier& b) {
    asm volatile("s_waitcnt vmcnt(0)" ::: "memory");
    __syncthreads();
    if (threadIdx.x == 0) {
        unsigned* bar = b.bar;
        __builtin_amdgcn_s_waitcnt(0);
        unsigned nloc = b.st[0], nx = b.st[1];
        if (nloc == 0u) { xcd_barrier_complete(bar, b.x, nloc, nx); b.st[0] = nloc; b.st[1] = nx; }
        const unsigned old = xb_add(&bar[XB_XSUB(b.x)], 1u);
        const unsigned gen = old / nloc;
        if (old + 1u == (gen + 1u) * nloc) {
            __builtin_amdgcn_fence(__ATOMIC_RELEASE, "agent");
            asm volatile("s_waitcnt vmcnt(0)" ::: "memory");
            const unsigned og = xb_add(&bar[XB_TOP], 1u);
            const unsigned tg = og / nx;
            if (og + 1u == (tg + 1u) * nx) xb_add(&bar[XB_TOPGEN], 1u);
            else XB_SPIN(xb_ld(&bar[XB_TOPGEN]) == tg, bar);
            __builtin_amdgcn_fence(__ATOMIC_ACQUIRE, "agent");
            xb_add(&bar[XB_XGEN(b.x)], 1u);
            asm volatile("s_waitcnt vmcnt(0)" ::: "memory");
        } else {
            XB_SPIN(xb_ld(&bar[XB_XGEN(b.x)]) == gen, bar);
            __builtin_amdgcn_fence(__ATOMIC_ACQUIRE, "agent");
            asm volatile("s_waitcnt vmcnt(0)" ::: "memory");
        }
    }
    __syncthreads();
}

constexpr int G_STAGE = 49152;
constexpr int G_LDS = 3 * G_STAGE;
template <int I, class AR, class BR, class KO>
DEV void naive_steps(f32x4 (&acc)[4][4], int nk, int mcnt, int wr, int wc, int fr, int fq, AR arow, BR brow, KO koff) {
    if constexpr (I < 64) {
        constexpr int m = I >> 4, n = (I >> 2) & 3, j = I & 3;
        if (m < mcnt) {
            const bf16_t* ap = arow(wr * 64 + m * 16 + fr);
            const bf16_t* bp = brow(wc * 64 + n * 16 + fq * 4 + j);
            float s = 0.f;
#pragma unroll 1
            for (int kc = 0; kc < nk; ++kc) {
                const u32x4* pa = (const u32x4*)(ap + koff(kc));
                const u32x4* pb = (const u32x4*)(bp + kc * 64);
#pragma unroll 2
                for (int c = 0; c < 8; ++c) {
                    const u32x4 va = pa[c], vb = pb[c];
#pragma unroll
                    for (int e = 0; e < 4; ++e) { s = fmaf(bflo(va[e]), bflo(vb[e]), s); s = fmaf(bfhi(va[e]), bfhi(vb[e]), s); }
                }
            }
            acc[m][n][j] += s;
        }
        naive_steps<I + 1>(acc, nk, mcnt, wr, wc, fr, fq, arow, brow, koff);
    }
}
struct GtPtrs { const bf16_t* pa0; const bf16_t* pa1; const bf16_t* pb0; const bf16_t* pb1; const bf16_t* pb2; const bf16_t* pb3; };
template <class AR, class BR>
DEV GtPtrs gt_ptrs(AR arow, BR brow) {
    const int tid = otid(), srow = tid >> 3, sx = ((tid & 7) ^ (srow & 7)) * 8;
    GtPtrs P; P.pa0 = arow(srow) + sx; P.pa1 = arow(srow + 64) + sx;
    P.pb0 = brow(srow) + sx; P.pb1 = brow(srow + 64) + sx; P.pb2 = brow(srow + 128) + sx; P.pb3 = brow(srow + 192) + sx;
    return P;
}
#define GLDS16(g, l) __builtin_amdgcn_global_load_lds((const unsigned*)(g), (unsigned*)(l), 16, 0, 0)
#define STAGE_T(so, kc) do { char* base_ = lds + (so) + threadIdx.x * 16; const int ka_ = koff(kc), kb_ = (kc) * 64; \
        GLDS16(P.pa0 + ka_, base_); GLDS16(P.pa1 + ka_, base_ + 8192); \
        GLDS16(P.pb0 + kb_, base_ + 16384); GLDS16(P.pb1 + kb_, base_ + 24576); GLDS16(P.pb2 + kb_, base_ + 32768); GLDS16(P.pb3 + kb_, base_ + 40960); } while (0)
template <class KO>
DEV void gt_issue2(char* lds, const GtPtrs& P, int nk, KO koff) {
    asm volatile("" ::: "memory");
    STAGE_T(0, 0);
    if (nk > 1) STAGE_T(G_STAGE, 1);
    asm volatile("" ::: "memory");
}
#define WAITV(n) asm volatile("s_waitcnt vmcnt(%0)" :: "i"(n) : "memory")
template <int NEPI, int MODE = 0, class KO>
DEV void gt_run(char* lds, f32x4 (&acc)[4][4], int nk, const GtPtrs& P, KO koff, bool pre, int nvalid = 128) {
    const int tid = threadIdx.x, lane = tid & 63, wid = tid >> 6, wr = wid >> 2, wc = wid & 3, fr = lane & 15, fq = lane >> 4;
    const int offk0 = ((fq ^ (fr & 7)) << 4), offk1 = (((4 + fq) ^ (fr & 7)) << 4);
    const int aoff = (wr * 64 + fr) * 128, boff = 16384 + (wc * 64 + fr) * 128;
    const int wru = __builtin_amdgcn_readfirstlane(wr);
    int mcnt = (nvalid - wru * 64 + 15) >> 4; mcnt = mcnt < 0 ? 0 : (mcnt > 4 ? 4 : mcnt);
#define GBAR() do { __builtin_amdgcn_sched_barrier(0); __builtin_amdgcn_s_barrier(); __builtin_amdgcn_sched_barrier(0); } while (0)
    if (NEPI > 0 && pre) { if (nk > 1) WAITV(6 + NEPI); else WAITV(NEPI); }
    else { if (nk > 1) WAITV(6); else WAITV(0); }
    GBAR();
    if (wru == 1) GBAR();
    int so = 0, so2 = 2 * G_STAGE;
#pragma unroll 1
    for (int t = 0; t < nk; ++t) {
        if (MODE != 2) { if (t + 2 < nk) STAGE_T(so2, t + 2); }
        const char* As = lds + so + aoff; const char* Bs = lds + so + boff;
        bf16x8 bq[4][2], aq[4][2];
        if (MODE != 3 || mcnt > 0) {
#pragma unroll
        for (int n = 0; n < 4; ++n) { bq[n][0] = *(const bf16x8*)(Bs + n * 2048 + offk0); bq[n][1] = *(const bf16x8*)(Bs + n * 2048 + offk1); }
#pragma unroll
        for (int m = 0; m < 4; ++m) { if (MODE != 3 || m == 0) { aq[m][0] = *(const bf16x8*)(As + m * 2048 + offk0); aq[m][1] = *(const bf16x8*)(As + m * 2048 + offk1); } }
        }
        if (NEPI > 0 && pre && t == 0) { if (t + 2 < nk) WAITV(6 + NEPI); else WAITV(NEPI); }
        else { if (t + 2 < nk) WAITV(6); else WAITV(0); }
        asm volatile("s_waitcnt lgkmcnt(0)" ::: "memory");
        GBAR();
        if (MODE == 1) {
#pragma unroll
            for (int m = 0; m < 4; ++m) { asm volatile("" :: "v"(aq[m][0]), "v"(aq[m][1]), "v"(bq[m][0]), "v"(bq[m][1])); }
        } else if (MODE == 3) {
            if (mcnt > 0) {
#pragma unroll
                for (int n = 0; n < 4; ++n) {
                    acc[0][n] = __builtin_amdgcn_mfma_f32_16x16x32_bf16(bq[n][0], aq[0][0], acc[0][n], 0, 0, 0);
                    acc[0][n] = __builtin_amdgcn_mfma_f32_16x16x32_bf16(bq[n][1], aq[0][1], acc[0][n], 0, 0, 0);
                }
            }
        } else {
        __builtin_amdgcn_s_setprio(1);
#pragma unroll
        for (int m = 0; m < 4; ++m)
#pragma unroll
            for (int n = 0; n < 4; ++n) {
                acc[m][n] = __builtin_amdgcn_mfma_f32_16x16x32_bf16(bq[n][0], aq[m][0], acc[m][n], 0, 0, 0);
                acc[m][n] = __builtin_amdgcn_mfma_f32_16x16x32_bf16(bq[n][1], aq[m][1], acc[m][n], 0, 0, 0);
            }
        __builtin_amdgcn_s_setprio(0);
        }
        GBAR();
        so2 = so; so = so + G_STAGE; if (so == 3 * G_STAGE) so = 0;
    }
    if (wru == 0) GBAR();
#undef GBAR
}
struct GtStream { int so; int wru; };
#define STAGE_PX(PP, KOFF, so_, kc) do { char* base_ = lds + (so_) + threadIdx.x * 16; const int ka_ = KOFF(kc), kb_ = (kc) * 64; \
        GLDS16((PP).pa0 + ka_, base_); GLDS16((PP).pa1 + ka_, base_ + 8192); \
        GLDS16((PP).pb0 + kb_, base_ + 16384); GLDS16((PP).pb1 + kb_, base_ + 24576); GLDS16((PP).pb2 + kb_, base_ + 32768); GLDS16((PP).pb3 + kb_, base_ + 40960); } while (0)
#define SBAR_() do { __builtin_amdgcn_sched_barrier(0); __builtin_amdgcn_s_barrier(); __builtin_amdgcn_sched_barrier(0); } while (0)
template <class KO>
DEV void gt_stream_begin(char* lds, GtStream& S, const GtPtrs& P, KO koff) {
    S.so = 0; S.wru = __builtin_amdgcn_readfirstlane((int)(threadIdx.x >> 8));
    asm volatile("" ::: "memory");
    STAGE_PX(P, koff, 0, 0); STAGE_PX(P, koff, G_STAGE, 1);
    asm volatile("" ::: "memory");
    WAITV(6);
    SBAR_();
    if (S.wru == 1) SBAR_();
}
template <int NEPI, class KO, class KON, class PNF>
DEV void gt_stream_tile(char* lds, GtStream& S, f32x4 (&acc)[4][4], int nk, const GtPtrs& P, KO koff, bool pre, bool has_next, PNF next_ptrs, KON koffn) {
    const int tid = threadIdx.x, lane = tid & 63, wid = tid >> 6, wr = wid >> 2, wc = wid & 3, fr = lane & 15, fq = lane >> 4;
    const int offk0 = ((fq ^ (fr & 7)) << 4), offk1 = (((4 + fq) ^ (fr & 7)) << 4);
    const int aoff = (wr * 64 + fr) * 128, boff = 16384 + (wc * 64 + fr) * 128;
    asm volatile("" ::: "memory");
    int so = S.so;
    GtPtrs Pn;
#pragma unroll 1
    for (int t = 0; t < nk; ++t) {
        int so2 = so + 2 * G_STAGE; if (so2 >= 3 * G_STAGE) so2 -= 3 * G_STAGE;
        const bool own = t + 2 < nk, nxt = !own && has_next;
        if (nxt && t + 2 == nk) Pn = next_ptrs();
        if (own) STAGE_PX(P, koff, so2, t + 2);
        else if (nxt) STAGE_PX(Pn, koffn, so2, t + 2 - nk);
        const char* As = lds + so + aoff; const char* Bs = lds + so + boff;
        bf16x8 bq[4][2], aq[4][2];
#pragma unroll
        for (int n = 0; n < 4; ++n) { bq[n][0] = *(const bf16x8*)(Bs + n * 2048 + offk0); bq[n][1] = *(const bf16x8*)(Bs + n * 2048 + offk1); }
#pragma unroll
        for (int m = 0; m < 4; ++m) { aq[m][0] = *(const bf16x8*)(As + m * 2048 + offk0); aq[m][1] = *(const bf16x8*)(As + m * 2048 + offk1); }
        if (t + 1 < nk || has_next) {
            if (NEPI > 0 && pre && t == 0) { if (own || nxt) WAITV(6 + NEPI); else WAITV(NEPI); }
            else { if (own || nxt) WAITV(6); else WAITV(0); }
        }
        asm volatile("s_waitcnt lgkmcnt(0)" ::: "memory");
        SBAR_();
        __builtin_amdgcn_s_setprio(1);
#pragma unroll
        for (int m = 0; m < 4; ++m)
#pragma unroll
            for (int n = 0; n < 4; ++n) {
                acc[m][n] = __builtin_amdgcn_mfma_f32_16x16x32_bf16(bq[n][0], aq[m][0], acc[m][n], 0, 0, 0);
                acc[m][n] = __builtin_amdgcn_mfma_f32_16x16x32_bf16(bq[n][1], aq[m][1], acc[m][n], 0, 0, 0);
            }
        __builtin_amdgcn_s_setprio(0);
        SBAR_();
        so += G_STAGE; if (so == 3 * G_STAGE) so = 0;
    }
    S.so = so;
    asm volatile("" ::: "memory");
}
DEV void gt_stream_end(GtStream& S) { if (S.wru == 0) SBAR_(); }
template <int MODE = 0, class AR, class BR, class KO>
DEV void gemm_tile(char* lds, f32x4 (&acc)[4][4], int nk, int nvalid, AR arow, BR brow, KO koff) {
    (void)nvalid;
#if NAIVE_GEMM
    const int tid = threadIdx.x, lane = tid & 63, wid = tid >> 6, wr = wid >> 2, wc = wid & 3, fr = lane & 15, fq = lane >> 4;
    naive_steps<0>(acc, nk, 4, wr, wc, fr, fq, arow, brow, koff);
#else
    const GtPtrs P = gt_ptrs(arow, brow);
    gt_issue2(lds, P, nk, koff);
    gt_run<0, MODE>(lds, acc, nk, P, koff, false);
#endif
}
DEV int pcol(int c) { return (c & 0xC3) | (((c >> 2) & 3) << 4) | (((c >> 4) & 3) << 2); }
DEV int rcol(int c) { const int n = (c >> 4) & 3, q = (c >> 2) & 3, e = c & 3; return (c & 0xC0) | ((n >> 1) << 5) | (q << 3) | ((n & 1) << 2) | e; }
DEV u32x4 pk8(f32x4 x, f32x4 y) { return u32x4{pk2(x[0], x[1]), pk2(x[2], x[3]), pk2(y[0], y[1]), pk2(y[2], y[3])}; }
DEV void zero_acc(f32x4 (&acc)[4][4]) {
#pragma unroll
    for (int m = 0; m < 4; ++m)
#pragma unroll
        for (int n = 0; n < 4; ++n) acc[m][n] = f32x4{0.f, 0.f, 0.f, 0.f};
}
DEV float tile_row_reduce(char* lds_red, const float (&ssq)[4]) {
    const int tid = otid(), lane = tid & 63, wid = tid >> 6, wr = wid >> 2, wc = wid & 3, fr = lane & 15, fq = lane >> 4;
    float* red = (float*)lds_red;
#pragma unroll
    for (int m = 0; m < 4; ++m) {
        float v = ssq[m]; v += __shfl_xor(v, 16); v += __shfl_xor(v, 32);
        if (fq == 0) red[(wr * 64 + m * 16 + fr) * 4 + wc] = v;
    }
    asm volatile("s_waitcnt lgkmcnt(0)" ::: "memory"); __builtin_amdgcn_s_barrier(); asm volatile("" ::: "memory");
    float r = 0.f;
    if (tid < 128) r = (red[tid * 4 + 0] + red[tid * 4 + 1]) + (red[tid * 4 + 2] + red[tid * 4 + 3]);
    asm volatile("s_waitcnt lgkmcnt(0)" ::: "memory"); __builtin_amdgcn_s_barrier(); asm volatile("" ::: "memory");
    return r;
}
constexpr int LDS_RED = G_LDS;
constexpr int LDS_TAB = G_LDS + 2048;


namespace pg8 {
#define PG8_LAS __attribute__((address_space(3)))
constexpr int BM = 256, BK = 64, HALF = 128, HTB = HALF * BK * 2, STAGE_BYTES = 8 * HTB;
DEV int lds_byte(int r, int c) { const int st = (r >> 4) * 2 + (c >> 5), rr = r & 15, cc = c & 31, ob = rr * 64 + cc * 2; return st * 1024 + (ob ^ (((ob >> 9) & 1) << 5)); }
DEV void stage_rc(int b, int& R, int& C) { const int st = b / 1024, sb = b % 1024, swz = sb ^ (((sb >> 9) & 1) << 5); R = (st >> 1) * 16 + swz / 64; C = (st & 1) * 32 + (swz % 64) / 2; }
DEV int perm32(int rho) { const int n = rho >> 4, i = rho & 15; return 8 * (i >> 2) + 4 * n + (i & 3); }
struct Unit { int pm, pn; };
template <class Epi, class Sched>
DEV void gemm_phase(char* lds_, int K, const Sched& S, const Epi& E) {
    PG8_LAS unsigned char* lds = (PG8_LAS unsigned char*)lds_;
    const int tid = threadIdx.x, wid = __builtin_amdgcn_readfirstlane(tid >> 6), lane = tid & 63, wr = wid >> 2, wc = wid & 3, fr = lane & 15, fq = lane >> 4;
    const int nt = K / BK;
    int sR[2], sC[2];
    unsigned voffA[2][2], voffAn[2][2], voffB[2][2], voffBn[2][2];
#pragma unroll
    for (int i = 0; i < 2; ++i) stage_rc(tid * 16 + i * 8192, sR[i], sC[i]);
    const size_t kstep = (size_t)(BK * 2);
    const unsigned ldsw = (unsigned)wid * 1024u;
    const int aoff = lds_byte(wr * 64 + fr, fq * 8), boff = lds_byte(wc * 32 + fr, fq * 8);
#define PG8_SA(b, h) (((b) * 2 + (h)) * HTB)
#define PG8_SB(b, h) ((4 + (b) * 2 + (h)) * HTB)
#define PG8_STAGEA(bufoff, gbase, h, usenext) do { _Pragma("unroll") for (int _i = 0; _i < 2; ++_i) \
        __builtin_amdgcn_global_load_lds((const unsigned*)((const char*)(gbase) + ((usenext) ? voffAn[h][_i] : voffA[h][_i])), (PG8_LAS unsigned*)(lds + (bufoff) + ldsw + _i * 8192), 16, 0, 0); } while (0)
#define PG8_STAGEB(bufoff, gbase, h, usenext) do { _Pragma("unroll") for (int _i = 0; _i < 2; ++_i) \
        __builtin_amdgcn_global_load_lds((const unsigned*)((const char*)(gbase) + ((usenext) ? voffBn[h][_i] : voffB[h][_i])), (PG8_LAS unsigned*)(lds + (bufoff) + ldsw + _i * 8192), 16, 0, 0); } while (0)
#define PG8_LDA(dst, b, h) do { _Pragma("unroll") for (int m = 0; m < 4; ++m) _Pragma("unroll") for (int k = 0; k < 2; ++k) dst[m][k] = *(const PG8_LAS bf16x8*)(lds + PG8_SA(b, h) + aoff + m * 2048 + k * 1024); } while (0)
#define PG8_LDB(dst, b, h) do { _Pragma("unroll") for (int n = 0; n < 2; ++n) _Pragma("unroll") for (int k = 0; k < 2; ++k) dst[n][k] = *(const PG8_LAS bf16x8*)(lds + PG8_SB(b, h) + boff + n * 2048 + k * 1024); } while (0)
#define PG8_MMA(ai, bj, At, Bt) do { __builtin_amdgcn_s_setprio(1); _Pragma("unroll") for (int m = 0; m < 4; ++m) _Pragma("unroll") for (int n = 0; n < 2; ++n) _Pragma("unroll") for (int k = 0; k < 2; ++k) \
        acc[ai][bj][m][n] = __builtin_amdgcn_mfma_f32_16x16x32_bf16(Bt[n][k], At[m][k], acc[ai][bj][m][n], 0, 0, 0); __builtin_amdgcn_s_setprio(0); } while (0)
#define PG8_WAIT_V(n) asm volatile("s_waitcnt vmcnt(" #n ")" ::: "memory")
#define PG8_WAIT_L(n) asm volatile("s_waitcnt lgkmcnt(" #n ")" ::: "memory")
#define PG8_BAR __builtin_amdgcn_s_barrier()
#define PG8_SCHED __builtin_amdgcn_sched_barrier(0)
    Unit cur, nxt; int ui = 0;
    if (!S.next(0, cur)) return;
    f32x4 acc[2][2][4][2];
#pragma unroll
    for (int a = 0; a < 2; ++a)
#pragma unroll
        for (int b = 0; b < 2; ++b)
#pragma unroll
            for (int m = 0; m < 4; ++m)
#pragma unroll
                for (int n = 0; n < 2; ++n) acc[a][b][m][n] = (f32x4){0.f, 0.f, 0.f, 0.f};
    bf16x8 At[4][2], B0[2][2], B1[2][2];
    const char* cA = S.a_base(cur); const char* cB = S.b_base(cur);
#pragma unroll
    for (int h = 0; h < 2; ++h)
#pragma unroll
        for (int i = 0; i < 2; ++i) { voffB[h][i] = (unsigned)((128 * h + S.b_row(cur, h, sR[i])) * K + sC[i]) * 2u;
            voffA[h][i] = (S.a_off(cur, h, sR[i]) + (unsigned)sC[i]) * 2u; }
    asm volatile("" ::: "memory");
    PG8_STAGEB(PG8_SB(0, 0), cB, 0, false); PG8_STAGEB(PG8_SB(0, 1), cB, 1, false); PG8_STAGEA(PG8_SA(0, 0), cA, 0, false); PG8_STAGEA(PG8_SA(0, 1), cA, 1, false);
    if (wr == 1) PG8_BAR;
    PG8_WAIT_V(2); PG8_BAR;
    PG8_STAGEB(PG8_SB(1, 0), cB + kstep, 0, false); PG8_STAGEA(PG8_SA(1, 0), cA + kstep, 0, false); PG8_STAGEB(PG8_SB(1, 1), cB + kstep, 1, false);
    PG8_WAIT_V(6); PG8_BAR;
    for (;;) {
        const bool has_next = S.next(ui + 1, nxt);
        const char* nA = has_next ? S.a_base(nxt) : cA; const char* nB = has_next ? S.b_base(nxt) : cB;
#pragma unroll
        for (int h = 0; h < 2; ++h)
#pragma unroll
            for (int i = 0; i < 2; ++i) { voffBn[h][i] = has_next ? (unsigned)((128 * h + S.b_row(nxt, h, sR[i])) * K + sC[i]) * 2u : voffB[h][i];
                voffAn[h][i] = has_next ? (S.a_off(nxt, h, sR[i]) + (unsigned)sC[i]) * 2u : voffA[h][i]; }
#pragma unroll 1
        for (int t = 0; t < nt; t += 2) {
            const bool last = (t == nt - 2);
            const char* a1 = cA + (size_t)(t + 1) * kstep;
            const char* a2 = last ? nA : cA + (size_t)(t + 2) * kstep; const char* b2 = last ? nB : cB + (size_t)(t + 2) * kstep;
            const char* a3 = a2 + kstep; const char* b3 = b2 + kstep;
            PG8_LDB(B0, 0, 0); PG8_LDB(B1, 0, 1); PG8_SCHED; PG8_LDA(At, 0, 0); PG8_STAGEA(PG8_SA(1, 1), a1, 1, false);
            PG8_WAIT_V(8); PG8_WAIT_L(0); PG8_BAR; PG8_MMA(0, 0, At, B0); PG8_MMA(0, 1, At, B1); PG8_BAR; PG8_SCHED;
            PG8_LDA(At, 0, 1); PG8_STAGEB(PG8_SB(0, 0), b2, 0, last); PG8_STAGEB(PG8_SB(0, 1), b2, 1, last); PG8_STAGEA(PG8_SA(0, 0), a2, 0, last);
            PG8_WAIT_V(8); PG8_WAIT_L(0); PG8_BAR; PG8_MMA(1, 0, At, B0); PG8_MMA(1, 1, At, B1); PG8_BAR; PG8_SCHED;
            PG8_LDB(B0, 1, 0); PG8_LDB(B1, 1, 1); PG8_SCHED; PG8_LDA(At, 1, 0); PG8_STAGEA(PG8_SA(0, 1), a2, 1, last);
            PG8_WAIT_V(8); PG8_WAIT_L(0); PG8_BAR; PG8_MMA(0, 0, At, B0); PG8_MMA(0, 1, At, B1); PG8_BAR; PG8_SCHED;
            PG8_LDA(At, 1, 1); PG8_STAGEB(PG8_SB(1, 0), b3, 0, last); PG8_STAGEB(PG8_SB(1, 1), b3, 1, last); PG8_STAGEA(PG8_SA(1, 0), a3, 0, last);
            PG8_WAIT_V(8); PG8_WAIT_L(0); PG8_BAR; PG8_MMA(1, 0, At, B0); PG8_MMA(1, 1, At, B1); PG8_BAR; PG8_SCHED;
        }
        if (wr == 0) PG8_BAR;
        E(acc, cur, wr, wc, fr, fq);
        if (!has_next) break;
#pragma unroll
        for (int a = 0; a < 2; ++a)
#pragma unroll
            for (int b = 0; b < 2; ++b)
#pragma unroll
                for (int m = 0; m < 4; ++m)
#pragma unroll
                    for (int n = 0; n < 2; ++n) acc[a][b][m][n] = (f32x4){0.f, 0.f, 0.f, 0.f};
        cur = nxt; cA = nA; cB = nB; ++ui;
#pragma unroll
        for (int h = 0; h < 2; ++h)
#pragma unroll
            for (int i = 0; i < 2; ++i) { voffB[h][i] = voffBn[h][i]; voffA[h][i] = voffAn[h][i]; }
        if (wr == 1) PG8_BAR;
    }
    PG8_WAIT_V(0);
    PG8_BAR;
#undef PG8_SA
#undef PG8_SB
#undef PG8_STAGEA
#undef PG8_STAGEB
#undef PG8_LDA
#undef PG8_LDB
#undef PG8_MMA
#undef PG8_WAIT_V
#undef PG8_WAIT_L
#undef PG8_BAR
#undef PG8_SCHED
}
}

DEV int rowmap(int mode, int n) { return mode == 0 ? n : ((n >> 7) * 256 + (n & 127) + (mode == 2 ? 128 : 0)); }
DEV void tr_tile(char* lds, const float* __restrict__ src, int ld, int k0, int n0, int nb, bf16_t* __restrict__ dst, int ldd, const float* sk, const float* sn, int mode) {
    const int tid = otid(), nl = tid & 63, kg = tid >> 6;
    float v[4][8];
#pragma unroll
    for (int j = 0; j < 4; ++j)
        if (j < nb) {
#pragma unroll
            for (int i = 0; i < 8; ++i) v[j][i] = src[(size_t)(k0 + kg * 8 + i) * ld + n0 + j * 64 + nl];
        }
    float skv[8];
#pragma unroll
    for (int i = 0; i < 8; ++i) skv[i] = sk ? sk[k0 + kg * 8 + i] : 1.f;
#pragma unroll
    for (int j = 0; j < 4; ++j)
        if (j < nb) {
            const float snv = sn ? sn[n0 + j * 64 + nl] : 1.f;
            const u32x4 w = {pk2(v[j][0] * skv[0] * snv, v[j][1] * skv[1] * snv), pk2(v[j][2] * skv[2] * snv, v[j][3] * skv[3] * snv),
                             pk2(v[j][4] * skv[4] * snv, v[j][5] * skv[5] * snv), pk2(v[j][6] * skv[6] * snv, v[j][7] * skv[7] * snv)};
            *(u32x4*)(lds + j * 9216 + nl * 144 + kg * 16) = w;
        }
    __syncthreads();
    const int r = tid >> 3, c = tid & 7;
#pragma unroll
    for (int j = 0; j < 4; ++j)
        if (j < nb) {
            const u32x4 o = *(const u32x4*)(lds + j * 9216 + r * 144 + c * 16);
            *(u32x4*)(dst + (size_t)rowmap(mode, n0 + j * 64 + r) * ldd + k0 + c * 8) = o;
        }
    __syncthreads();
}
constexpr int TR_SMALL = 212, TR_MOE = 1536;
DEV void tr_small_job(char* lds, const Args& a, int i) {
    unsigned char* ws = a.ws;
    if (i < 16) { const int g = i >> 2, kt = i & 3;
        tr_tile(lds, a.a_w + (size_t)g * 65536, 256, kt * 64, 0, 4, (bf16_t*)(ws + WS_AWT) + (size_t)g * 65536, 256, a.a_norm + g * 256, a.a_scale + g * 256, 0); return; }
    i -= 16;
    if (i < 32) { const int kt = i >> 1, h = i & 1;
        tr_tile(lds, a.w_dkv, 320, kt * 64, h * 256, h ? 1 : 4, (bf16_t*)(ws + WS_WCAT), 1024, a.kv_norm, nullptr, 0); return; }
    i -= 32;
    if (i < 32) { const int kt = i >> 1, h = i & 1;
        tr_tile(lds, a.w_dq, 384, kt * 64, h * 256, h ? 2 : 4, (bf16_t*)(ws + WS_WCAT) + (size_t)320 * 1024, 1024, a.b_norm, nullptr, 0); return; }
    i -= 32;
    if (i < 16) { const int kt = i >> 2, ng = i & 3;
        tr_tile(lds, a.w_uk, 1024, kt * 64, ng * 256, 4, (bf16_t*)(ws + WS_WUKV), 256, a.kv_lat_norm, nullptr, 0); return; }
    i -= 16;
    if (i < 16) { const int kt = i >> 2, ng = i & 3;
        tr_tile(lds, a.w_uv, 1024, kt * 64, ng * 256, 4, (bf16_t*)(ws + WS_WUKV) + (size_t)1024 * 256, 256, a.kv_lat_norm, nullptr, 0); return; }
    i -= 16;
    if (i < 36) { const int kt = i / 6, ng = i % 6;
        tr_tile(lds, a.w_uq, 1536, kt * 64, ng * 256, 4, (bf16_t*)(ws + WS_WUQ), 384, a.q_norm, nullptr, 0); return; }
    i -= 36;
    { const int kt = i >> 2, ng = i & 3;
        tr_tile(lds, a.w_o, 1024, kt * 64, ng * 256, 4, (bf16_t*)(ws + WS_WO), 1024, nullptr, nullptr, 0); }
}
DEV void tr_moe_job(char* lds, const Args& a, int l, int i) {
    unsigned char* ws = a.ws;
    const int e = i / 48, r = i % 48;
    const size_t eo = (size_t)(l * NE + e) * 262144;
    if (r < 32) { const int up = r >> 4, kt = r & 15;
        tr_tile(lds, (up ? a.w_up : a.w_gate) + eo, 256, kt * 64, 0, 4, (bf16_t*)(ws + WS_WGU) + (size_t)e * 524288, 1024, a.ffn_norm + l * 1024, nullptr, up ? 2 : 1); }
    else { const int rr = r - 32, kt = rr >> 2, ng = rr & 3;
        tr_tile(lds, a.w_down + eo, 1024, kt * 64, ng * 256, 4, (bf16_t*)(ws + WS_WD) + (size_t)e * 262144, 256, nullptr, nullptr, 0); }
}
DEV void phase_prologue(char* lds, const Args& a) {
    const int G = gridDim.x, bid = blockIdx.x, tid = threadIdx.x;
    unsigned char* ws = a.ws;
    const int gt = bid * NTHR + tid, GT = G * NTHR;
    bf16_t* WRT = (bf16_t*)(ws + WS_WRT);
    for (int i = gt; i < 2 * 48 * 1024; i += GT) { const int l = i / 49152, r = i % 49152, o = r >> 10, k = r & 1023;
        float w = 0.f;
        if (o < 36) w = (o < 4 ? a.router_g[(size_t)(l * 1024 + k) * 4 + o] : a.router_e[(size_t)(l * 1024 + k) * 32 + (o - 4)]) * a.ffn_norm[l * 1024 + k];
        const unsigned hi = pk2(w, 0.f) & 0xffffu; const float lo = w - __uint_as_float(hi << 16);
        WRT[(size_t)l * 98304 + r] = (bf16_t)hi; WRT[(size_t)l * 98304 + 49152 + r] = (bf16_t)(pk2(lo, 0.f) & 0xffffu); }
    float* BI = (float*)(ws + WS_BIAS);
    for (int i = gt; i < 128; i += GT) { const int l = i >> 6, o = i & 63; BI[i] = o < 4 ? a.router_g_bias[l * 4 + o] : (o < 36 ? a.router_e_bias[l * 32 + o - 4] : 0.f); }
    float* COS = (float*)(ws + WS_COS); float* SIN = (float*)(ws + WS_SIN);
    for (int i = gt; i < 4112 * 32; i += GT) { const int p = i >> 5, f = i & 31;
        const double inv = pow(10000.0, -(double)f / 32.0), ang = (double)p * inv; COS[i] = (float)cos(ang); SIN[i] = (float)sin(ang); }
    u32x4* wz = (u32x4*)((bf16_t*)(ws + WS_WCAT) + (size_t)704 * 1024);
    for (int i = gt; i < 64 * 1024 / 8; i += GT) wz[i] = u32x4{0u, 0u, 0u, 0u};
    for (int i = bid; i < TR_SMALL; i += G) tr_small_job(lds, a, i);
}

template <int W>
DEV void pool_cols(char* lds, const Args& a, int b, int pstart, int nrows, int first_out, bf16_t* __restrict__ po_base  , int c0) {
    const int tid = otid(), lane = tid & 63, wid = tid >> 6;
    float* part = (float*)lds;
    float* rsb = (float*)(lds + 512);
    f32x2 ring[16]; f32x2 sum = {0.f, 0.f};
#pragma unroll
    for (int j = 0; j < 16; ++j) ring[j] = f32x2{0.f, 0.f};
    f32x2 ldn[16];
#pragma unroll
    for (int j = 0; j < 16; ++j) { const int ii = j < nrows ? j : nrows - 1; ldn[j] = *(const f32x2*)(seq_row(a, b, pstart + ii) + c0); }
#pragma unroll 1
    for (int ib = 0; ib < nrows; ib += 16) {
        f32x2 ld[16];
#pragma unroll
        for (int j = 0; j < 16; ++j) ld[j] = ldn[j];
        if (ib + 16 < nrows) {
#pragma unroll
            for (int j = 0; j < 16; ++j) { const int i = ib + 16 + j; const int ii = i < nrows ? i : nrows - 1;
                ldn[j] = *(const f32x2*)(seq_row(a, b, pstart + ii) + c0); }
        }
#pragma unroll
        for (int j = 0; j < 16; ++j) { const float p = wave_sum(ld[j][0] * ld[j][0] + ld[j][1] * ld[j][1]); if (lane == 0) part[wid * 16 + j] = p; }
        asm volatile("s_waitcnt lgkmcnt(0)" ::: "memory"); __builtin_amdgcn_s_barrier(); asm volatile("" ::: "memory");
        if (tid < 16) { const float sq = ((part[tid] + part[16 + tid]) + (part[32 + tid] + part[48 + tid])) + ((part[64 + tid] + part[80 + tid]) + (part[96 + tid] + part[112 + tid]));
            rsb[tid] = rsqrtf(sq * (1.f / D) + EPS); }
        asm volatile("s_waitcnt lgkmcnt(0)" ::: "memory"); __builtin_amdgcn_s_barrier(); asm volatile("" ::: "memory");
#pragma unroll
        for (int j = 0; j < 16; ++j) { const int i = ib + j;
            if (i < nrows) {
                const float r = rsb[j]; const f32x2 v = {ld[j][0] * r, ld[j][1] * r};
                const f32x2 old = ring[(j - W) & 15];
                sum[0] += v[0] - old[0]; sum[1] += v[1] - old[1];
                ring[j] = v;
                if (i >= first_out) { const int pos = pstart + i; const float ic = 1.f / (float)(pos + 1 < W ? pos + 1 : W);
                    *(unsigned*)(po_base + (size_t)(i - first_out) * D + c0) = pk2(sum[0] * ic - v[0], sum[1] * ic - v[1]); }
            }
        }
    }
}
DEV void pool_unit(char* lds, const Args& a, int u) {
    const int tid = otid(), wid = tid >> 6;
    bf16_t* PO = (bf16_t*)(a.ws + WS_B);
    int b, pstart, nrows, first_out, t0;
    if (u < 256) { b = u >> 5; const int s0 = (u & 31) * 128; pstart = s0 + 1; nrows = 143; first_out = 15; t0 = u * 128; }
    else { b = 0; pstart = 0; nrows = 16; first_out = 0; t0 = NREAL; }
    __syncthreads();
    const int c0 = tid * 2, g = __builtin_amdgcn_readfirstlane(wid >> 1);
    bf16_t* pob = PO + (size_t)t0 * D;
    if (g == 0) pool_cols<2>(lds, a, b, pstart, nrows, first_out, pob, c0);
    else if (g == 1) pool_cols<4>(lds, a, b, pstart, nrows, first_out, pob, c0);
    else if (g == 2) pool_cols<8>(lds, a, b, pstart, nrows, first_out, pob, c0);
    else pool_cols<16>(lds, a, b, pstart, nrows, first_out, pob, c0);
    __syncthreads();
}

constexpr int R_PART = 0;
constexpr int R_HIST = 98304, R_ENT = R_HIST + 256;
DEV void router_acc(f32x4 (&racc)[4][3], const f32x4 (&hh)[4][4], const bf16_t* WH, const bf16_t* WL, int colbase, int fr, int fq) {
#pragma unroll
    for (int kk = 0; kk < 2; ++kk) {
        bf16x8 bh[3], bl[3];
#pragma unroll
        for (int n = 0; n < 3; ++n) { const size_t o = (size_t)(n * 16 + fr) * 1024 + colbase + fq * 16 + kk * 8; bh[n] = *(const bf16x8*)(WH + o); bl[n] = *(const bf16x8*)(WL + o); }
#pragma unroll
        for (int m = 0; m < 4; ++m) {
            const f32x4 v0 = hh[m][2 * kk], v1 = hh[m][2 * kk + 1];
            const unsigned h0 = pk2(v0[0], v0[1]), h1 = pk2(v0[2], v0[3]), h2 = pk2(v1[0], v1[1]), h3 = pk2(v1[2], v1[3]);
            const u32x4 hv = {h0, h1, h2, h3};
            const u32x4 lv = {pk2(v0[0] - bflo(h0), v0[1] - bfhi(h0)), pk2(v0[2] - bflo(h1), v0[3] - bfhi(h1)), pk2(v1[0] - bflo(h2), v1[1] - bfhi(h2)), pk2(v1[2] - bflo(h3), v1[3] - bfhi(h3))};
            const bf16x8 ah = __builtin_bit_cast(bf16x8, hv), al = __builtin_bit_cast(bf16x8, lv);
#pragma unroll
            for (int n = 0; n < 3; ++n) {
                racc[m][n] = __builtin_amdgcn_mfma_f32_16x16x32_bf16(ah, bh[n], racc[m][n], 0, 0, 0);
                racc[m][n] = __builtin_amdgcn_mfma_f32_16x16x32_bf16(al, bh[n], racc[m][n], 0, 0, 0);
                racc[m][n] = __builtin_amdgcn_mfma_f32_16x16x32_bf16(ah, bl[n], racc[m][n], 0, 0, 0);
            }
        }
    }
}
DEV void router_part_store(char* lds, const f32x4 (&racc)[4][3], int wr, int wc, int fr, int fq) {
    float* part = (float*)(lds + R_PART);
#pragma unroll
    for (int m = 0; m < 4; ++m)
#pragma unroll
        for (int n = 0; n < 3; ++n)
#pragma unroll
            for (int e = 0; e < 4; ++e) part[(wc * 128 + wr * 64 + m * 16 + fq * 4 + e) * 48 + n * 16 + fr] = racc[m][n][e];
}
DEV void mixer_unit(char* lds, const Args& a, int u) {
    const int tid = otid(), lane = tid & 63, wid = tid >> 6, wr = wid >> 2, wc = wid & 3, fr = lane & 15, fq = lane >> 4;
    const bf16_t* PO = (const bf16_t*)(a.ws + WS_B);
    const bf16_t* AWT = (const bf16_t*)(a.ws + WS_AWT);
    bf16_t* HB = (bf16_t*)(a.ws + WS_HB); float* RSTD = (float*)(a.ws + WS_RSTD);
    {
        const int t0 = u * 128, nvalid = u < 256 ? 128 : 16;
        float ssq[4] = {0.f, 0.f, 0.f, 0.f};
        f32x4 racc[4][3];
#pragma unroll
        for (int m = 0; m < 4; ++m)
#pragma unroll
            for (int n = 0; n < 3; ++n) racc[m][n] = f32x4{0.f, 0.f, 0.f, 0.f};
        const bf16_t* WH = (const bf16_t*)(a.ws + WS_WRT); const bf16_t* WL = WH + 49152;
        auto koff = [](int kc) { return kc * 64; };
        const bool full = nvalid == 128;
        { const GtPtrs P0 = gt_ptrs([&](int r) { return PO + (size_t)(t0 + (r < nvalid ? r : 0)) * D; }, [&](int c) { return AWT + (size_t)pcol(c) * 256; });
          gt_issue2(lds, P0, 4, koff); }
        bool pre = false;
#pragma unroll 1
        for (int g = 0; g < 4; ++g) {
            f32x4 acc[4][4]; zero_acc(acc);
            const GtPtrs P = gt_ptrs([&](int r) { return PO + (size_t)(t0 + (r < nvalid ? r : 0)) * D + g * 256; }, [&](int c) { return AWT + (size_t)g * 65536 + (size_t)pcol(c) * 256; });
            if (full) gt_run<16>(lds, acc, 4, P, koff, pre); else gt_run<0, 3>(lds, acc, 4, P, koff, false, nvalid);
            const int tid = otid(), lane = tid & 63, wid = tid >> 6, wr = wid >> 2, wc = wid & 3, fr = lane & 15, fq = lane >> 4;
            f32x4 hh[4][4];
#pragma unroll
            for (int m = 0; m < 4; ++m) { const int r = wr * 64 + m * 16 + fr; const float* hr = h0_row(a, t0 + (r < nvalid ? r : 0)) + g * 256 + wc * 64 + fq * 16;
#pragma unroll
                for (int n = 0; n < 4; ++n) hh[m][n] = *(const f32x4*)(hr + n * 4); }
#pragma unroll
            for (int m = 0; m < 4; ++m)
#pragma unroll
                for (int n = 0; n < 4; ++n) hh[m][n] += acc[m][n];
            router_acc(racc, hh, WH, WL, g * 256 + wc * 64, fr, fq);
#pragma unroll
            for (int m = 0; m < 4; ++m)
#pragma unroll
                for (int n = 0; n < 3; ++n) asm volatile("" : "+v"(racc[m][n]));
            if (g < 3) { const int g1 = g + 1;
                const GtPtrs Pn = gt_ptrs([&](int r) { return PO + (size_t)(t0 + (r < nvalid ? r : 0)) * D + g1 * 256; }, [&](int c) { return AWT + (size_t)g1 * 65536 + (size_t)pcol(c) * 256; });
                gt_issue2(lds, Pn, 4, koff); }
            pre = full;
#pragma unroll
            for (int m = 0; m < 4; ++m) { const int r = wr * 64 + m * 16 + fr;
                if (r < nvalid) { const int t = t0 + r;
                    const int col0 = g * 256 + wc * 64 + fq * 16;
#pragma unroll
                    for (int n = 0; n < 4; ++n) { const f32x4 h = hh[m][n];
                        ssq[m] += h[0] * h[0] + h[1] * h[1] + h[2] * h[2] + h[3] * h[3]; }
                    *(u32x4*)(HB + (size_t)t * D + col0) = pk8(hh[m][0], hh[m][1]); *(u32x4*)(HB + (size_t)t * D + col0 + 8) = pk8(hh[m][2], hh[m][3]); } }
        }
        const float tot = tile_row_reduce(lds + LDS_RED, ssq);
        if (tid < nvalid) RSTD[t0 + tid] = rsqrtf(tot * (1.f / D) + EPS);
        router_part_store(lds, racc, wr, wc, fr, fq);
    }
}

DEV void router_decide(char* lds, const Args& a, int layer, int t0, int nvalid, bool dry) {
    const int tid = otid();
    const float* BI = (const float*)(a.ws + WS_BIAS) + layer * 64;
    const float* RSTD = (const float*)(a.ws + WS_RSTD);
    int* CNT = (int*)(a.ws + WS_CTL + CTL_CNT) + layer * 32; int* LISTS = (int*)(a.ws + WS_LISTS); float* GATEW = (float*)(a.ws + WS_GATEW);
    float* part = (float*)(lds + R_PART);
    int* hist = (int*)(lds + R_HIST); int* base = hist + 32; int* ent_e = (int*)(lds + R_ENT); int* ent_rank = ent_e + 256;
    if (tid < 32) hist[tid] = 0;
    __syncthreads();
    if (tid < nvalid) {
        const int t = t0 + tid; const float rs = RSTD[t];
        const float* p0 = part + tid * 48;
        float g[4];
#pragma unroll
        for (int i = 0; i < 4; ++i) g[i] = ((p0[i] + p0[6144 + i]) + (p0[12288 + i] + p0[18432 + i])) * rs + BI[i];
        int gs = 0; float gm = g[0];
#pragma unroll
        for (int i = 1; i < 4; ++i) if (g[i] > gm) { gm = g[i]; gs = i; }
        float den = 0.f;
#pragma unroll
        for (int i = 0; i < 4; ++i) den += __expf(g[i] - gm);
        const float wg = 1.f / den;
        float m1 = -3.0e38f, m2 = -3.0e38f; int i1 = 0, i2 = 0;
#pragma unroll
        for (int i = 0; i < 8; ++i) { const int o = 4 + gs * 8 + i;
            const float x = ((p0[o] + p0[6144 + o]) + (p0[12288 + o] + p0[18432 + o])) * rs + BI[o];
            if (x > m1) { m2 = m1; i2 = i1; m1 = x; i1 = i; } else if (x > m2) { m2 = x; i2 = i; } }
        const float ex = __expf(m2 - m1), s1 = 1.f / (1.f + ex), s2 = ex * s1;
        const int e1 = gs * 8 + i1, e2 = gs * 8 + i2;
        if (!dry) { GATEW[2 * t] = wg * s1; GATEW[2 * t + 1] = wg * s2; }
        ent_e[2 * tid] = e1; ent_rank[2 * tid] = atomicAdd(&hist[e1], 1);
        ent_e[2 * tid + 1] = e2; ent_rank[2 * tid + 1] = atomicAdd(&hist[e2], 1);
    }
    __syncthreads();
    if (tid < 32) base[tid] = (hist[tid] && !dry) ? atomicAdd(&CNT[tid], hist[tid]) : 0;
    __syncthreads();
    if (tid < 2 * nvalid && !dry) { const int e = ent_e[tid]; LISTS[(size_t)e * M1 + base[e] + ent_rank[tid]] = 2 * (t0 + (tid >> 1)) + (tid & 1); }
    __syncthreads();
}
DEV void phase_front(char* lds, const Args& a, bool dry = false) {
    for (int u = blockIdx.x; u < 257; u += gridDim.x) {
        pool_unit(lds, a, u);
        mixer_unit(lds, a, u);
        __syncthreads();
        router_decide(lds, a, 0, u * 128, u < 256 ? 128 : 16, dry);
    }
    if (!dry && blockIdx.x > 0) { __syncthreads(); for (int i = blockIdx.x - 1; i < TR_MOE; i += gridDim.x - 1) tr_moe_job(lds, a, 0, i); }
}
DEV void moe_tables(char* lds, const Args& a, int layer) {
    int* tab = (int*)(lds + LDS_TAB); int* tstart = tab; int* rstart = tab + 33; int* cnt = tab + 66;
    int* CNT = (int*)(a.ws + WS_CTL + CTL_CNT) + layer * 32;
    if (threadIdx.x == 0) { int ts = 0, rsum = 0;
        for (int e = 0; e < 32; ++e) { const int c = __hip_atomic_load(&CNT[e], __ATOMIC_RELAXED, __HIP_MEMORY_SCOPE_AGENT); cnt[e] = c; tstart[e] = ts; rstart[e] = rsum; ts += (c + 127) >> 7; rsum += c; }
        tstart[32] = ts; rstart[32] = rsum; }
    __syncthreads();
}
DEV int vbid() { const int G = gridDim.x, b = blockIdx.x; return (G & 7) ? b : (b & 7) * (G >> 3) + (b >> 3); }
template <class BR>
DEV void gt_ptrs_b(GtPtrs& P, BR brow) {
    const int tid = otid(), srow = tid >> 3, sx = ((tid & 7) ^ (srow & 7)) * 8;
    P.pb0 = brow(srow) + sx; P.pb1 = brow(srow + 64) + sx; P.pb2 = brow(srow + 128) + sx; P.pb3 = brow(srow + 192) + sx;
}
struct MoeItem { int ti, nt0, nt1; };
template <int NTN>
DEV bool moe_item(int T, int k, MoeItem& it) {
    const int G = gridDim.x, v = vbid(), R = T / G, L = T - R * G;
    if (k < R) { it.ti = k * G + v; it.nt0 = 0; it.nt1 = NTN; return true; }
    const int s = v + G * (k - R);
    if (s >= L * NTN) return false;
    it.ti = R * G + s / NTN; it.nt0 = s % NTN; it.nt1 = it.nt0 + 1; return true;
}
constexpr int M2_TAB = 131072;
constexpr int M2_ROWS = M2_TAB + 512;
struct Moe1Sched { const char* lds; const bf16_t* HB; const bf16_t* WGU; int L0, L1, ti0;
    DEV void locate(int ti, int& e, int& tile) const { const int* t256 = (const int*)(lds + M2_TAB); e = 0; while (t256[e + 1] <= ti) ++e; tile = ti - t256[e]; }
    DEV bool next(int i, pg8::Unit& u) const { const int L = L0 + i; if (L >= L1) return false; u.pm = L >> 1; u.pn = L & 1; return true; }
    DEV const char* a_base(const pg8::Unit&) const { return (const char*)HB; }
    DEV const char* b_base(const pg8::Unit& u) const { int e, tile; locate(u.pm, e, tile); return (const char*)(WGU + (size_t)e * 524288 + (size_t)u.pn * 262144); }
    DEV unsigned a_off(const pg8::Unit& u, int h, int R) const { const int* rtok = (const int*)(lds + M2_ROWS) + (u.pm - ti0) * 256; const int t = rtok[128 * h + R]; return (unsigned)(t < 0 ? 0 : t) * 1024u; }
    DEV int b_row(const pg8::Unit&, int, int R) const { return (R & ~31) + pg8::perm32(R & 31); } };
struct Moe1Epi { const char* lds; bf16_t* ACT; int ti0;
    DEV void operator()(const f32x4 (&acc)[2][2][4][2], const pg8::Unit& u, int wr, int wc, int fr, int fq) const {
        const int* t256 = (const int*)(lds + M2_TAB); const int* rst = t256 + 33;
        int e = 0; while (t256[e + 1] <= u.pm) ++e; const int tile = u.pm - t256[e];
        const int* rtok = (const int*)(lds + M2_ROWS) + (u.pm - ti0) * 256; const float* rrs = (const float*)(lds + M2_ROWS + 3 * 1024) + (u.pm - ti0) * 256;
#pragma unroll
        for (int ai = 0; ai < 2; ++ai)
#pragma unroll
            for (int m = 0; m < 4; ++m) { const int r = ai * 128 + wr * 64 + m * 16 + fr;
                if (rtok[r] >= 0) { const float rs = rrs[r];
                    f32x4 o[2];
#pragma unroll
                    for (int n = 0; n < 2; ++n)
#pragma unroll
                        for (int j = 0; j < 4; ++j) { const float g = acc[ai][0][m][n][j] * rs, up = acc[ai][1][m][n][j] * rs; o[n][j] = g / (1.f + __expf(-g)) * up; }
                    *(u32x4*)(ACT + (size_t)(rst[e] + tile * 256 + r) * 256 + u.pn * 128 + wc * 32 + fq * 8) = pk8(o[0], o[1]); } }
    } };
DEV void phase_moe1(char* lds, const Args& a, int layer) {
    const int tid = otid();
    int* CNT = (int*)(a.ws + WS_CTL + CTL_CNT) + layer * 32;
    int* t256 = (int*)(lds + M2_TAB); int* rst = t256 + 33; int* cntl = t256 + 66;
    if (tid == 0) { int ts = 0, rsum = 0;
        for (int e = 0; e < 32; ++e) { const int c = __hip_atomic_load(&CNT[e], __ATOMIC_RELAXED, __HIP_MEMORY_SCOPE_AGENT); cntl[e] = c; t256[e] = ts; rst[e] = rsum; ts += (c + 255) >> 8; rsum += c; }
        t256[32] = ts; rst[32] = rsum; }
    __syncthreads();
    const int Ut = t256[32] * 2, G = gridDim.x, c = vbid(), q = Ut / G, rem = Ut % G;
    const int L0 = c * q + (c < rem ? c : rem), L1 = L0 + q + (c < rem ? 1 : 0);
    const int ti0 = L0 >> 1, ti1 = L1 > L0 ? ((L1 - 1) >> 1) : ti0 - 1;
    const int* LISTS = (const int*)(a.ws + WS_LISTS); const float* RSTD = (const float*)(a.ws + WS_RSTD);
    int* rtok = (int*)(lds + M2_ROWS); float* rrs = (float*)(lds + M2_ROWS + 3 * 1024);
    for (int k = 0; k <= ti1 - ti0 && k < 3; ++k) {
        const int ti = ti0 + k; int e = 0; while (t256[e + 1] <= ti) ++e; const int tile = ti - t256[e];
        if (tid < 256) { const int r = tile * 256 + tid; const bool ok = r < cntl[e];
            const int tok = ok ? (LISTS[(size_t)e * M1 + r] >> 1) : -1; rtok[k * 256 + tid] = tok; rrs[k * 256 + tid] = ok ? RSTD[tok] : 0.f; } }
    __syncthreads();
    const Moe1Sched S{lds, (const bf16_t*)(a.ws + WS_HB), (const bf16_t*)(a.ws + WS_WGU), L0, (ti1 - ti0 < 3) ? L1 : L0, ti0};
    const Moe1Epi E{lds, (bf16_t*)(a.ws + WS_D), ti0};
    pg8::gemm_phase(lds, 1024, S, E);
}

struct Moe2Sched { const char* lds; const bf16_t* ACT; const bf16_t* WDT; int L0, L1;
    DEV void locate(int ti, int& e, int& tile) const { const int* t256 = (const int*)(lds + M2_TAB); e = 0; while (t256[e + 1] <= ti) ++e; tile = ti - t256[e]; }
    DEV bool next(int i, pg8::Unit& u) const { const int L = L0 + i; if (L >= L1) return false; u.pm = L >> 2; u.pn = L & 3; return true; }
    DEV const char* a_base(const pg8::Unit& u) const { int e, tile; locate(u.pm, e, tile); const int* rst = (const int*)(lds + M2_TAB) + 33; return (const char*)(ACT + (size_t)(rst[e] + tile * 256) * 256); }
    DEV const char* b_base(const pg8::Unit& u) const { int e, tile; locate(u.pm, e, tile); return (const char*)(WDT + (size_t)e * 262144 + (size_t)u.pn * 65536); }
    DEV unsigned a_off(const pg8::Unit&, int h, int R) const { return (unsigned)((128 * h + R) * 256); }
    DEV int b_row(const pg8::Unit&, int, int R) const { return (R & ~31) + pg8::perm32(R & 31); } };
struct Moe2Epi { const char* lds; bf16_t* Y; int ti0;
    DEV void operator()(const f32x4 (&acc)[2][2][4][2], const pg8::Unit& u, int wr, int wc, int fr, int fq) const {
        const int* rslot = (const int*)(lds + M2_ROWS) + (u.pm - ti0) * 256; const float* rgw = (const float*)(lds + M2_ROWS + 3 * 1024) + (u.pm - ti0) * 256;
#pragma unroll
        for (int ai = 0; ai < 2; ++ai)
#pragma unroll
            for (int m = 0; m < 4; ++m) { const int r = ai * 128 + wr * 64 + m * 16 + fr; const int slot = rslot[r];
                if (slot >= 0) { const float gw = rgw[r]; bf16_t* yr = Y + (size_t)slot * D + u.pn * 256 + wc * 32 + fq * 8;
#pragma unroll
                    for (int bj = 0; bj < 2; ++bj) *(u32x4*)(yr + bj * 128) = pk8(acc[ai][bj][m][0] * gw, acc[ai][bj][m][1] * gw); } }
    } };
DEV void phase_moe2(char* lds, const Args& a, int layer) {
    const int tid = otid();
    int* CNT = (int*)(a.ws + WS_CTL + CTL_CNT) + layer * 32;
    int* t256 = (int*)(lds + M2_TAB); int* rst = t256 + 33; int* cntl = t256 + 66;
    if (tid == 0) { int ts = 0, rsum = 0;
        for (int e = 0; e < 32; ++e) { const int c = __hip_atomic_load(&CNT[e], __ATOMIC_RELAXED, __HIP_MEMORY_SCOPE_AGENT); cntl[e] = c; t256[e] = ts; rst[e] = rsum; ts += (c + 255) >> 8; rsum += c; }
        t256[32] = ts; rst[32] = rsum; }
    __syncthreads();
    const int Ut = t256[32] * 4, G = gridDim.x, c = vbid(), q = Ut / G, rem = Ut % G;
    const int L0 = c * q + (c < rem ? c : rem), L1 = L0 + q + (c < rem ? 1 : 0);
    const int ti0 = L0 >> 2, ti1 = L1 > L0 ? ((L1 - 1) >> 2) : ti0 - 1;
    const int* LISTS = (const int*)(a.ws + WS_LISTS); const float* GATEW = (const float*)(a.ws + WS_GATEW);
    int* rslot = (int*)(lds + M2_ROWS); float* rgw = (float*)(lds + M2_ROWS + 3 * 1024);
    for (int k = 0; k <= ti1 - ti0 && k < 3; ++k) {
        const int ti = ti0 + k; int e = 0; while (t256[e + 1] <= ti) ++e; const int tile = ti - t256[e];
        if (tid < 256) { const int r = tile * 256 + tid; const bool ok = r < cntl[e];
            const int sl = ok ? LISTS[(size_t)e * M1 + r] : -1; rslot[k * 256 + tid] = sl; rgw[k * 256 + tid] = ok ? GATEW[sl] : 0.f; } }
    __syncthreads();
    const Moe2Sched S{lds, (const bf16_t*)(a.ws + WS_D), (const bf16_t*)(a.ws + WS_WD), L0, (ti1 - ti0 < 3) ? L1 : L0};
    const Moe2Epi E{lds, (bf16_t*)(a.ws + WS_B), ti0};
    pg8::gemm_phase(lds, 256, S, E);
}

DEV void combine_unit(char* lds, const Args& a, int t0, int nvalid, bf16_t* dst) {
    const int tid = otid(), lane = tid & 63, wid = tid >> 6;
    const bf16_t* HB = (const bf16_t*)(a.ws + WS_HB); float* RSTD = (float*)(a.ws + WS_RSTD); const bf16_t* Y = (const bf16_t*)(a.ws + WS_B);
#pragma unroll 4
    for (int i = 0; i < 16; ++i) {
        const int r = wid * 16 + i;
        if (r < nvalid) {
            const int t = t0 + r;
            float s = 0.f;
#pragma unroll
            for (int q = 0; q < 2; ++q) { const int col = q * 512 + lane * 8;
                const u32x4 hb = *(const u32x4*)(HB + (size_t)t * D + col);
                const u32x4 y0 = *(const u32x4*)(Y + (size_t)(2 * t) * D + col), y1 = *(const u32x4*)(Y + (size_t)(2 * t + 1) * D + col);
                u32x4 o;
#pragma unroll
                for (int j = 0; j < 4; ++j) { const float lo = bflo(hb[j]) + (bflo(y0[j]) + bflo(y1[j])), hi = bfhi(hb[j]) + (bfhi(y0[j]) + bfhi(y1[j]));
                    o[j] = pk2(lo, hi); s += lo * lo + hi * hi; }
                *(u32x4*)(dst + (size_t)r * D + col) = o; }
            s = wave_sum(s);
            if (lane == 0) { const float rsv = rsqrtf(s * (1.f / D) + EPS); RSTD[t] = rsv; ((float*)(lds + LDS_TAB))[r] = rsv; }
        }
    }
}

template <int nt, class NEXT>
DEV void latent_tile(char* lds, const Args& a, int mt, const GtPtrs& P, bool pre, NEXT issue_next) {
    const int tid = otid(), lane = tid & 63, wid = tid >> 6, wr = wid >> 2, wc = wid & 3, fr = lane & 15, fq = lane >> 4;
    float* RSTDC = (float*)(a.ws + WS_RSTDC); float* SSQQ = (float*)(a.ws + WS_SSQQ);
    bf16_t* CRAW = (bf16_t*)(a.ws + WS_C); bf16_t* KR = (bf16_t*)(a.ws + WS_KR);
    const float* COS = (const float*)(a.ws + WS_COS); const float* SIN = (const float*)(a.ws + WS_SIN);
    {
        const int t0 = mt * 128, nvalid = mt < 256 ? 128 : 16;
        f32x4 acc[4][4]; zero_acc(acc);
        if (nvalid == 128) gt_run<8>(lds, acc, 16, P, [](int kc) { return kc * 64; }, pre); else gt_run<0, 3>(lds, acc, 16, P, [](int kc) { return kc * 64; }, false, nvalid);
        issue_next();
        const float* rstd_l = (const float*)(lds + LDS_TAB);
        float ssq[4] = {0.f, 0.f, 0.f, 0.f};
#pragma unroll
        for (int m = 0; m < 4; ++m) { const int r = wr * 64 + m * 16 + fr;
            if (r < nvalid) { const int t = t0 + r; const float rs = rstd_l[r];
#pragma unroll
                for (int n = 0; n < 4; ++n) acc[m][n] *= rs;
                if (nt == 1 && wc == 0) {
                    const int p = t < NREAL ? NMETA + (t & (SEQ - 1)) : t - NREAL;
#pragma unroll
                    for (int n = 0; n < 2; ++n) { const int i0 = fq * 8 + n * 4;
                        const f32x4 cs = *(const f32x4*)(COS + p * 32 + i0), sn = *(const f32x4*)(SIN + p * 32 + i0);
                        const f32x4 x1 = acc[m][n], x2 = acc[m][n + 2];
                        const f32x4 o1 = x1 * cs - x2 * sn, o2 = x1 * sn + x2 * cs;
                        const u32x2 w1 = {pk2(o1[0], o1[1]), pk2(o1[2], o1[3])}, w2 = {pk2(o2[0], o2[1]), pk2(o2[2], o2[3])};
                        if (t < NREAL) { bf16_t* kr = KR + ((size_t)(t >> 12) * LP + p) * 64 + i0; *(u32x2*)kr = w1; *(u32x2*)(kr + 32) = w2; }
                        else { for (int b = 0; b < NB; ++b) { bf16_t* kr = KR + ((size_t)b * LP + p) * 64 + i0; *(u32x2*)kr = w1; *(u32x2*)(kr + 32) = w2; } } }
                } else {
                    const int col = nt * 256 + wc * 64 + fq * 16;
                    if (col < 704) { const int cc = col < 256 ? col : col - 64;
                        *(u32x4*)(CRAW + (size_t)t * 640 + cc) = pk8(acc[m][0], acc[m][1]); *(u32x4*)(CRAW + (size_t)t * 640 + cc + 8) = pk8(acc[m][2], acc[m][3]);
#pragma unroll
                        for (int n = 0; n < 4; ++n)
                            ssq[m] += acc[m][n][0] * acc[m][n][0] + acc[m][n][1] * acc[m][n][1] + acc[m][n][2] * acc[m][n][2] + acc[m][n][3] * acc[m][n][3]; }
                } } }
        const float tot = tile_row_reduce(lds + LDS_RED, ssq);
        if (tid < nvalid) { const int t = t0 + tid;
            if (nt == 0) RSTDC[t] = rsqrtf(tot * (1.f / KVLR) + EPS);
            else if (t < NREAL) SSQQ[2 * t + (nt - 1)] = tot; }
    }
}

DEV void phase_comb_latent(char* lds, const Args& a) {
    bf16_t* HB = (bf16_t*)(a.ws + WS_HB); const bf16_t* WCAT = (const bf16_t*)(a.ws + WS_WCAT);
    auto koff = [](int kc) { return kc * 64; };
    for (int u = blockIdx.x; u < 256; u += gridDim.x) {
        combine_unit(lds, a, u * 128, 128, HB + (size_t)u * 128 * D);
        __syncthreads();
        const int t0 = u * 128;
        auto arow = [&](int r) { return HB + (size_t)(t0 + r) * D; };
        GtPtrs P = gt_ptrs(arow, [&](int c) { return WCAT + (size_t)pcol(c) * 1024; });
        gt_issue2(lds, P, 16, koff);
        GtPtrs P1, P2;
        { int u0 = u; asm volatile("" : "+s"(u0));
          latent_tile<0>(lds, a, u0, P, false, [&]() { P1 = gt_ptrs(arow, [&](int c) { return WCAT + (size_t)(256 + (c < 64 ? rcol(c) : pcol(c))) * 1024; }); gt_issue2(lds, P1, 16, koff); }); }
        { int u1 = u; asm volatile("" : "+s"(u1));
          latent_tile<1>(lds, a, u1, P1, true, [&]() { P2 = gt_ptrs(arow, [&](int c) { return WCAT + (size_t)(512 + pcol(c)) * 1024; }); gt_issue2(lds, P2, 16, koff); }); }
        { int u2 = u; asm volatile("" : "+s"(u2)); latent_tile<2>(lds, a, u2, P2, true, [&]() {}); }
    }
    for (int j = blockIdx.x; j < 2; j += gridDim.x) {
        __syncthreads();
        bf16_t* HM = (bf16_t*)(a.ws + WS_HMETA) + (size_t)j * 16 * D;
        combine_unit(lds, a, NREAL, 16, HM);
        __syncthreads();
        auto arow = [&](int r) { return HM + (size_t)(r < 16 ? r : 0) * D; };
        if (j == 0) { const GtPtrs P = gt_ptrs(arow, [&](int c) { return WCAT + (size_t)pcol(c) * 1024; }); gt_issue2(lds, P, 16, koff);
            int u0 = 256; asm volatile("" : "+s"(u0)); latent_tile<0>(lds, a, u0, P, false, [&]() {}); }
        else { const GtPtrs P = gt_ptrs(arow, [&](int c) { return WCAT + (size_t)(256 + (c < 64 ? rcol(c) : pcol(c))) * 1024; }); gt_issue2(lds, P, 16, koff);
            int u1 = 256; asm volatile("" : "+s"(u1)); latent_tile<1>(lds, a, u1, P, false, [&]() {}); }
    }
}

struct UpSchedKV { const bf16_t* A; const bf16_t* Bt;
    DEV bool next(int i, pg8::Unit& u) const { if (i >= 4) return false; const int L = 4 * (int)blockIdx.x + i; if (L >= 1024) return false; u.pm = L >> 3; u.pn = L & 7; return true; }
    DEV const char* a_base(const pg8::Unit& u) const { return (const char*)(A + (size_t)u.pm * 256 * 640); }
    DEV const char* b_base(const pg8::Unit& u) const { return (const char*)(Bt + (size_t)u.pn * 256 * 256); }
    DEV unsigned a_off(const pg8::Unit&, int h, int R) const { return (unsigned)((128 * h + R) * 640); }
    DEV int b_row(const pg8::Unit&, int, int R) const { return (R & ~31) + pg8::perm32(R & 31); } };
struct UpEpiKV { const Args* a;
    DEV void operator()(const f32x4 (&acc)[2][2][4][2], const pg8::Unit& u, int wr, int wc, int fr, int fq) const {
        const float* RSTDC = (const float*)(a->ws + WS_RSTDC); bf16_t* dst = (bf16_t*)(a->ws + (u.pn < 4 ? WS_D : WS_A));
#pragma unroll
        for (int ai = 0; ai < 2; ++ai)
#pragma unroll
            for (int m = 0; m < 4; ++m) { const int t = u.pm * 256 + ai * 128 + wr * 64 + m * 16 + fr; const float rs = RSTDC[t];
                bf16_t* o = dst + ((size_t)(t >> 12) * LP + NMETA + (t & (SEQ - 1))) * 1024 + (u.pn & 3) * 256 + wc * 32 + fq * 8;
#pragma unroll
                for (int bj = 0; bj < 2; ++bj) *(u32x4*)(o + bj * 128) = pk8(acc[ai][bj][m][0] * rs, acc[ai][bj][m][1] * rs); }
    } };
struct UpSchedQ { const bf16_t* A; const bf16_t* Bt;
    DEV bool next(int i, pg8::Unit& u) const { if (i >= 3) return false; const int L = 3 * (int)blockIdx.x + i; if (L >= 768) return false; u.pm = L / 6; u.pn = L % 6; return true; }
    DEV const char* a_base(const pg8::Unit& u) const { return (const char*)(A + (size_t)u.pm * 256 * 640 + 256); }
    DEV const char* b_base(const pg8::Unit& u) const { return (const char*)(Bt + (size_t)u.pn * 256 * 384); }
    DEV unsigned a_off(const pg8::Unit&, int h, int R) const { return (unsigned)((128 * h + R) * 640); }
    DEV int b_row(const pg8::Unit& u, int h, int R) const {
        if ((u.pn * 4 + h * 2 + (R >> 6)) % 3 == 2) { const int r6 = R & 63, g = r6 >> 5, n = (r6 >> 4) & 1, i = r6 & 15; return (R & 64) + n * 32 + g * 16 + i; }
        return (R & ~31) + pg8::perm32(R & 31); } };
struct UpEpiQ { const Args* a;
    DEV void operator()(const f32x4 (&acc)[2][2][4][2], const pg8::Unit& u, int wr, int wc, int fr, int fq) const {
        const float* SSQQ = (const float*)(a->ws + WS_SSQQ); bf16_t* Q = (bf16_t*)(a->ws + WS_B);
        const float* COS = (const float*)(a->ws + WS_COS); const float* SIN = (const float*)(a->ws + WS_SIN);
#pragma unroll
        for (int ai = 0; ai < 2; ++ai)
#pragma unroll
            for (int m = 0; m < 4; ++m) { const int t = u.pm * 256 + ai * 128 + wr * 64 + m * 16 + fr;
                const float rs = rsqrtf((SSQQ[2 * t] + SSQQ[2 * t + 1]) * (1.f / QLR) + EPS);
                bf16_t* qrow = Q + (size_t)t * 1536 + u.pn * 256;
#pragma unroll
                for (int bj = 0; bj < 2; ++bj) {
                    if ((u.pn * 4 + bj * 2 + (wc >> 1)) % 3 == 2) {
                        const int p = NMETA + (t & (SEQ - 1)), i0 = (wc & 1) * 16 + fq * 4;
                        const f32x4 cs = *(const f32x4*)(COS + p * 32 + i0), sn = *(const f32x4*)(SIN + p * 32 + i0);
                        const f32x4 x1 = acc[ai][bj][m][0] * rs, x2 = acc[ai][bj][m][1] * rs;
                        const f32x4 o1 = x1 * cs - x2 * sn, o2 = x1 * sn + x2 * cs;
                        bf16_t* o = qrow + bj * 128 + (wc >> 1) * 64 + i0;
                        *(u32x2*)o = u32x2{pk2(o1[0], o1[1]), pk2(o1[2], o1[3])}; *(u32x2*)(o + 32) = u32x2{pk2(o2[0], o2[1]), pk2(o2[2], o2[3])};
                    } else *(u32x4*)(qrow + bj * 128 + wc * 32 + fq * 8) = pk8(acc[ai][bj][m][0] * rs, acc[ai][bj][m][1] * rs);
                } }
    } };
DEV void phase_up(char* lds, const Args& a) {
    const int tid = otid(), lane = tid & 63, wid = tid >> 6, wr = wid >> 2, wc = wid & 3, fr = lane & 15, fq = lane >> 4;
    const bf16_t* CRAW = (const bf16_t*)(a.ws + WS_C); const bf16_t* WUKV = (const bf16_t*)(a.ws + WS_WUKV); const bf16_t* WUQ = (const bf16_t*)(a.ws + WS_WUQ);
    const float* RSTDC = (const float*)(a.ws + WS_RSTDC);
    bf16_t* KN = (bf16_t*)(a.ws + WS_D); bf16_t* V = (bf16_t*)(a.ws + WS_A);
    { const int gt = blockIdx.x * NTHR + tid, GT = gridDim.x * NTHR;
      for (int i = gt; i < NB * 48 * 128; i += GT) { const int b = i / (48 * 128), r = i % (48 * 128);
          *(u32x4*)(V + ((size_t)b * LP + 4112) * 1024 + (size_t)r * 8) = u32x4{0u, 0u, 0u, 0u}; } }
    { const UpSchedKV S{CRAW, WUKV}; const UpEpiKV E{&a}; pg8::gemm_phase(lds, 256, S, E); }
    { const UpSchedQ S{CRAW, WUQ}; const UpEpiQ E{&a}; pg8::gemm_phase(lds, 384, S, E); }
    auto koff = [](int kc) { return kc * 64; };
    for (int j = blockIdx.x; j < 8; j += gridDim.x) {
        __syncthreads();
        const int nt = j;
        f32x4 acc[4][4]; zero_acc(acc);
        const GtPtrs P = gt_ptrs([&](int r) { return CRAW + (size_t)(NREAL + (r < 16 ? r : 0)) * 640; }, [&](int c) { return WUKV + (size_t)(nt * 256 + pcol(c)) * 256; });
        gt_issue2(lds, P, 4, koff);
        gt_run<0, 3>(lds, acc, 4, P, koff, false, 16);
        bf16_t* dst = nt < 4 ? KN : V;
        if (wr == 0) { const int r = fr; const float rs = RSTDC[NREAL + r];
            const int colb = (nt & 3) * 256 + wc * 64 + fq * 16;
            const u32x4 w0 = pk8(acc[0][0] * rs, acc[0][1] * rs), w1 = pk8(acc[0][2] * rs, acc[0][3] * rs);
            for (int b = 0; b < NB; ++b) { bf16_t* o = dst + ((size_t)b * LP + r) * 1024 + colb; *(u32x4*)o = w0; *(u32x4*)(o + 8) = w1; } }
    }
}

#if NAIVE_ATTN
DEV void phase_attn(char* lds, const Args& a) {
    (void)lds;
    const int tid = threadIdx.x, lane = tid & 63, wid = tid >> 6;
    bf16_t* Q = (bf16_t*)(a.ws + WS_B); const bf16_t* KN = (const bf16_t*)(a.ws + WS_D); const bf16_t* V = (const bf16_t*)(a.ws + WS_A); const bf16_t* KR = (const bf16_t*)(a.ws + WS_KR);
    const int nw = gridDim.x * 8;
    for (int task = blockIdx.x * 8 + wid; task < NB * NH * SEQ; task += nw) {
        const int s = task & (SEQ - 1), bh = task >> 12, b = bh >> 3, h = bh & 7;
        const int t = b * SEQ + s;
        bf16_t* q = Q + (size_t)t * 1536 + h * 192;
        const float q0 = bf2f(q[lane]), q1 = bf2f(q[lane + 64]), q2 = bf2f(q[128 + lane]);
        float mx = -1e30f, l = 0.f, o0 = 0.f, o1 = 0.f;
        const int nkeys = NMETA + s + 1;
        for (int j = 0; j < nkeys; ++j) {
            const size_t kr = (size_t)b * LP + j;
            const bf16_t* kn = KN + kr * 1024 + h * 128; const bf16_t* kp = KR + kr * 64; const bf16_t* vp = V + kr * 1024 + h * 128;
            float sc = q0 * bf2f(kn[lane]) + q1 * bf2f(kn[lane + 64]) + q2 * bf2f(kp[lane]);
            sc = wave_sum(sc) * ATTN_SCALE;
            const float mn = fmaxf(mx, sc), al = __expf(mx - mn), p = __expf(sc - mn);
            l = l * al + p; o0 = o0 * al + p * bf2f(vp[lane]); o1 = o1 * al + p * bf2f(vp[lane + 64]); mx = mn;
        }
        const float il = 1.f / l;
        const unsigned w0 = pk2(o0 * il, 0.f), w1 = pk2(o1 * il, 0.f);
        q[lane] = (bf16_t)(w0 & 0xffff); q[lane + 64] = (bf16_t)(w1 & 0xffff);
    }
}
#endif


#if !NAIVE_ATTN
namespace att {
typedef short s16x4 __attribute__((ext_vector_type(4)));
typedef float f32x16 __attribute__((ext_vector_type(16)));
constexpr int NW = 8, QBLK = 32, KVBLK = 64, QB = 256;
constexpr int SHM_V = 64 * 128 * 2, SHM_K = 64 * 192 * 2;
constexpr int QS = 1536, KNS = 1024, KRS = 64, VS = 1024, OS = 1536;
constexpr float THR = 8.f;
constexpr float SCALE = ATTN_SCALE;
constexpr int NQB = SEQ / QB;
#ifndef ATT_NQR
#define ATT_NQR 5
#endif
constexpr int NQR = ATT_NQR;
constexpr int Q_LDS = 2 * SHM_V + 2 * SHM_K + 2048;
#define KSWZ(row, colB) ((row) * 384 + ((colB) ^ ((((row) >> 1) & 7) << 4)))
#define SBAR() __builtin_amdgcn_sched_barrier(0)
DEV int v_st(int k, int c) { const int kk = (k & ~0xC) | ((k & 4) << 1) | ((k & 8) >> 1); return ((kk >> 3) * 4 + (c >> 5)) * 512 + ((kk & 7) * 32 + (c & 31)) * 2; }
DEV int v_rd_base(int lane) { return ((lane & 3) << 3) | (((lane >> 2) & 3) << 6) | (((lane >> 4) & 1) << 5) | (((lane >> 5) & 1) << 8); }
constexpr int v_rd_off(int d0, int ks, int half) { return d0 * 512 + ks * 4096 + half * 2048; }
DEV int crow(int r, int hi) { return (r & 3) + 8 * (r >> 2) + 4 * hi; }
DEV unsigned cvtpk(float lo, float hi) { unsigned r; asm volatile("v_cvt_pk_bf16_f32 %0, %1, %2" : "=v"(r) : "v"(lo), "v"(hi)); return r; }
DEV void mask_tile(f32x16& p0, f32x16& p1, int dq) {
    const float NEG = -__builtin_inff();
#pragma unroll
    for (int r = 0; r < 16; ++r) {
        const int c = (r & 3) + 8 * (r >> 2);
        if (dq - c < 0) p0[r] = NEG;
        if (dq - c - 32 < 0) p1[r] = NEG;
    }
}
DEV void partialSM(f32x16& p0, f32x16& p1, float& m_reg, float& mn, float& alpha) {
    float pmax = p0[0];
#pragma unroll
    for (int r = 1; r < 16; ++r) pmax = fmaxf(pmax, p0[r]);
#pragma unroll
    for (int r = 0; r < 16; ++r) pmax = fmaxf(pmax, p1[r]);
    { auto rr = __builtin_amdgcn_permlane32_swap(__float_as_uint(pmax), __float_as_uint(pmax), false, false);
      pmax = fmaxf(__uint_as_float(rr[0]), __uint_as_float(rr[1])); }
    constexpr float C2 = 1.4426950408889634f * SCALE;
    if (__builtin_expect(__all((pmax - m_reg) * SCALE <= THR), 1)) { mn = m_reg; alpha = 1.f; }
    else { mn = fmaxf(m_reg, pmax); alpha = __builtin_amdgcn_exp2f((m_reg - mn) * C2); m_reg = mn; }
    const float mnL = -mn * C2;
#pragma unroll
    for (int r = 0; r < 16; ++r) p0[r] = fmaf(p0[r], C2, mnL);
#pragma unroll
    for (int r = 0; r < 16; ++r) p1[r] = fmaf(p1[r], C2, mnL);
#pragma unroll
    for (int r = 0; r < 16; ++r) p0[r] = __builtin_amdgcn_exp2f(p0[r]);
}
DEV void finishSM(f32x16& p0, f32x16& p1, float alpha, float& l_reg, bf16x8& pa0, bf16x8& pa1, bf16x8& pa2, bf16x8& pa3) {
#pragma unroll
    for (int r = 0; r < 16; ++r) p1[r] = __builtin_amdgcn_exp2f(p1[r]);
    float ps = 0;
#pragma unroll
    for (int r = 0; r < 16; ++r) ps += p0[r];
#pragma unroll
    for (int r = 0; r < 16; ++r) ps += p1[r];
    { auto rr = __builtin_amdgcn_permlane32_swap(__float_as_uint(ps), __float_as_uint(ps), false, false);
      ps = __uint_as_float(rr[0]) + __uint_as_float(rr[1]); }
    l_reg = l_reg * alpha + ps;
#define PK4(P, B_, OUT) do { unsigned a0 = cvtpk(P[B_+0], P[B_+1]), a1 = cvtpk(P[B_+2], P[B_+3]);                          \
        unsigned b0 = cvtpk(P[B_+4], P[B_+5]), b1 = cvtpk(P[B_+6], P[B_+7]);                                             \
        auto r0 = __builtin_amdgcn_permlane32_swap(a0, b0, false, false); auto r1 = __builtin_amdgcn_permlane32_swap(a1, b1, false, false); \
        u32x4 w = {r0[0], r1[0], r0[1], r1[1]}; OUT = *reinterpret_cast<bf16x8*>(&w); } while (0)
    PK4(p0, 0, pa0); PK4(p0, 8, pa1); PK4(p1, 0, pa2); PK4(p1, 8, pa3);
#undef PK4
}
template <int KB>
DEV void qkt(f32x16& p0, f32x16& p1, const char* K_lds, int r32, int hi, const bf16x8* qr, const char* qlds) {
    p0 = f32x16{}; p1 = f32x16{};
    const char* kb[4];
#pragma unroll
    for (int dd = 0; dd < 4; ++dd) kb[dd] = K_lds + KB * SHM_K + KSWZ(r32, (dd * 16 + hi * 8) * 2);
#pragma unroll
    for (int d0 = 0; d0 < 12; ++d0) { const char* a = kb[d0 & 3] + (d0 >> 2) * 128;
        bf16x8 b0 = *reinterpret_cast<const bf16x8*>(a);
        bf16x8 b1 = *reinterpret_cast<const bf16x8*>(a + 32 * 384);
        bf16x8 q;
        if (d0 < NQR) q = qr[d0 < NQR ? d0 : 0]; else q = *reinterpret_cast<const bf16x8*>(qlds + (d0 - NQR) * 1024);
        p0 = __builtin_amdgcn_mfma_f32_32x32x16_bf16(b0, q, p0, 0, 0, 0);
        p1 = __builtin_amdgcn_mfma_f32_32x32x16_bf16(b1, q, p1, 0, 0, 0); }
}
template <int VB>
DEV void pv_tile(f32x16* o, int vb0, bf16x8 pa0, bf16x8 pa1, bf16x8 pa2, bf16x8 pa3) {
#define TRRD(dst, off) asm volatile("ds_read_b64_tr_b16 %0, %1 offset:%2" : "=&v"(dst) : "v"(vb0), "i"(off) : "memory")
#define PV_D0(d0) do { s16x4 l0, l1, l2, l3, h0, h1, h2, h3; constexpr int b_ = VB * SHM_V + v_rd_off(d0, 0, 0); \
        TRRD(l0, b_); TRRD(h0, b_ + 2048); TRRD(l1, b_ + 4096); TRRD(h1, b_ + 6144); TRRD(l2, b_ + 8192); TRRD(h2, b_ + 10240); TRRD(l3, b_ + 12288); TRRD(h3, b_ + 14336); \
        asm volatile("s_waitcnt lgkmcnt(0)" ::: "memory"); SBAR();   \
        o[d0] = __builtin_amdgcn_mfma_f32_32x32x16_bf16(pa0, (bf16x8){l0[0], l0[1], l0[2], l0[3], h0[0], h0[1], h0[2], h0[3]}, o[d0], 0, 0, 0);   \
        o[d0] = __builtin_amdgcn_mfma_f32_32x32x16_bf16(pa1, (bf16x8){l1[0], l1[1], l1[2], l1[3], h1[0], h1[1], h1[2], h1[3]}, o[d0], 0, 0, 0);   \
        o[d0] = __builtin_amdgcn_mfma_f32_32x32x16_bf16(pa2, (bf16x8){l2[0], l2[1], l2[2], l2[3], h2[0], h2[1], h2[2], h2[3]}, o[d0], 0, 0, 0);   \
        o[d0] = __builtin_amdgcn_mfma_f32_32x32x16_bf16(pa3, (bf16x8){l3[0], l3[1], l3[2], l3[3], h3[0], h3[1], h3[2], h3[3]}, o[d0], 0, 0, 0); } while (0)
    PV_D0(0); PV_D0(1); PV_D0(2); PV_D0(3);
#undef PV_D0
#undef TRRD
}
struct BlockRef { const bf16_t* Q; const bf16_t* Kn; const bf16_t* Kr; const bf16_t* V; bf16_t* O; int P0; };
struct Seam { bf16x8 qr[NQR]; bf16x8 st0, st1, st2; };
#define VMW() asm volatile("s_waitcnt vmcnt(0)" ::: "memory")
#define SLOAD_K(R, k0) do { const bf16_t* kn_ = (R).Kn + (size_t)(k0) * KNS; const bf16_t* kr2_ = (R).Kr + (size_t)(k0) * KRS; \
        S.st0 = *(const bf16x8*)(kn_ + offKn); S.st1 = *(const bf16x8*)(kn_ + offKn + 64); S.st2 = *(const bf16x8*)(kr2_ + offKr); } while (0)
#define SLOAD_V(R, k0) do { const bf16_t* vb_ = (R).V + (size_t)(k0) * VS; S.st0 = *(const bf16x8*)(vb_ + offV); S.st1 = *(const bf16x8*)(vb_ + offV + 32 * VS); } while (0)
#define SWRITE_K(bf) do { *(bf16x8*)(K_lds + (bf) * SHM_K + kws) = S.st0; *(bf16x8*)(K_lds + (bf) * SHM_K + kws + 128) = S.st1; *(bf16x8*)(K_lds + (bf) * SHM_K + kws + 256) = S.st2; } while (0)
#define SWRITE_V(bf) do { *(bf16x8*)(V_lds + (bf) * SHM_V + vst0) = S.st0; *(bf16x8*)(V_lds + (bf) * SHM_V + vst1) = S.st1; } while (0)
DEV void prime(const BlockRef& cur, char* lds, Seam& S) {
    const int tid = threadIdx.x;
    const int sr = tid >> 4, sc = (tid & 15) * 8, kr_ = tid >> 3, kc8 = (tid & 7) * 8, kws = KSWZ(kr_, kc8 * 2); char* K_lds = lds + 2 * SHM_V;
    const unsigned offV = sr * VS + sc, offKn = kr_ * KNS + kc8, offKr = kr_ * KRS + kc8;
    SLOAD_K(cur, 0); VMW(); SWRITE_K(0); SBAR(); SLOAD_V(cur, 0);
    __syncthreads();
}
DEV void block(const BlockRef& cur, const BlockRef& nxt, char* lds, Seam& S) {
    const int tid = threadIdx.x, wid = __builtin_amdgcn_readfirstlane(tid >> 6), lane = tid & 63, r32 = lane & 31, hi = lane >> 5;
    const int NT = (cur.P0 + QB - 1) / KVBLK + 1;
    const int qlo = cur.P0 + wid * QBLK, qm = qlo + r32 - 4 * hi;
    char* V_lds = lds; char* K_lds = lds + 2 * SHM_V;
    float* ws = (float*)(lds + 2 * SHM_V + 2 * SHM_K) + wid * 64; float* li_l = ws, * al_l = ws + 32;
    float m_reg = -1e30f, l_reg = 0; f32x16 o[4] = {};
    const int sr = tid >> 4, sc = (tid & 15) * 8, vst0 = v_st(sr, sc), vst1 = v_st(32 + sr, sc);
    const int kr_ = tid >> 3, kc8 = (tid & 7) * 8, kws = KSWZ(kr_, kc8 * 2);
    const unsigned offV = sr * VS + sc, offKn = kr_ * KNS + kc8, offKr = kr_ * KRS + kc8;
    const int vb0 = (int)(uintptr_t)V_lds + v_rd_base(lane);
#define RESC(a) do { if (__any((a) < 1.f)) { if (hi == 0) al_l[r32] = (a); asm volatile("s_waitcnt lgkmcnt(0)" ::: "memory");              \
                     for (int d_ = 0; d_ < 4; ++d_) for (int r = 0; r < 16; ++r) o[d_][r] *= al_l[crow(r, hi)]; } } while (0)
#define KBASE(t) ((t) * KVBLK)
#define MASKT(P0_, P1_, t) do { const int kb_ = KBASE(t); if (kb_ + KVBLK - 1 > qlo) mask_tile(P0_, P1_, qm - kb_); } while (0)
    f32x16 pA0, pA1, pB0, pB1; float mnA, mnB, alA, alB; bf16x8 pa0, pa1, pa2, pa3;
    char* qlds = lds + Q_LDS + wid * ((12 - NQR) * 1024) + lane * 16;
    VMW(); SWRITE_V(0); SBAR();
    { const bf16_t* qrow = cur.Q + (size_t)(wid * QBLK + r32) * QS + hi * 8;
#pragma unroll
      for (int d0 = 0; d0 < NQR; ++d0) S.qr[d0] = *(const bf16x8*)(qrow + d0 * 16);
#pragma unroll
      for (int d0 = NQR; d0 < 12; ++d0) { const bf16x8 tq = *(const bf16x8*)(qrow + d0 * 16); *(bf16x8*)(qlds + (d0 - NQR) * 1024) = tq; } }
    SBAR();
    SLOAD_K(cur, KBASE(1));
    SBAR(); qkt<0>(pA0, pA1, K_lds, r32, hi, S.qr, qlds);
    VMW(); SWRITE_K(1); SBAR(); SLOAD_V(cur, KBASE(1));
    MASKT(pA0, pA1, 0); partialSM(pA0, pA1, m_reg, mnA, alA);
    VMW(); SWRITE_V(1); SBAR(); SLOAD_K(cur, KBASE(2));
    __syncthreads();
#define HALF_STEP(PX0, PX1, mnX, alX, PY0, PY1, alY, t, KB, VB, SB) do {                                                      \
        SBAR(); qkt<KB>(PX0, PX1, K_lds, r32, hi, S.qr, qlds);                                                                \
        finishSM(PY0, PY1, alY, l_reg, pa0, pa1, pa2, pa3); SBAR();                                                           \
        if ((t) + 1 < NT) { VMW(); SWRITE_K(SB); SBAR(); SLOAD_V(cur, KBASE((t) + 1)); } SBAR();                              \
        pv_tile<VB>(o, vb0, pa0, pa1, pa2, pa3); MASKT(PX0, PX1, (t)); partialSM(PX0, PX1, m_reg, mnX, alX);                  \
        __syncthreads();                                                                                                      \
        if ((t) + 1 < NT) { VMW(); SWRITE_V(SB); SBAR(); if ((t) + 2 < NT) SLOAD_K(cur, KBASE((t) + 2)); }                    \
        RESC(alX); __syncthreads(); } while (0)
    for (int t = 1; t + 1 < NT; t += 2) {
        HALF_STEP(pB0, pB1, mnB, alB, pA0, pA1, alA, t, 1, 0, 0);
        HALF_STEP(pA0, pA1, mnA, alA, pB0, pB1, alB, t + 1, 0, 1, 1);
    }
    const bool even = (NT & 1) == 0;
    if (even) { SBAR(); qkt<1>(pB0, pB1, K_lds, r32, hi, S.qr, qlds); SBAR(); }
    SLOAD_K(nxt, 0); SBAR();
    finishSM(pA0, pA1, alA, l_reg, pa0, pa1, pa2, pa3); SBAR();
    pv_tile<0>(o, vb0, pa0, pa1, pa2, pa3);
    if (even) { MASKT(pB0, pB1, NT - 1); partialSM(pB0, pB1, m_reg, mnB, alB); __syncthreads(); RESC(alB);
        finishSM(pB0, pB1, alB, l_reg, pa0, pa1, pa2, pa3); SBAR(); pv_tile<1>(o, vb0, pa0, pa1, pa2, pa3); }
    SBAR(); VMW(); SWRITE_K(0); SBAR(); SLOAD_V(nxt, 0); SBAR();
    if (hi == 0) li_l[r32] = l_reg; asm volatile("s_waitcnt lgkmcnt(0)" ::: "memory");
    float rli[16];
#pragma unroll
    for (int r = 0; r < 16; ++r) rli[r] = __builtin_amdgcn_rcpf(li_l[crow(r, hi)]);
    bf16_t* Ow = cur.O + (size_t)(wid * QBLK) * OS;
#pragma unroll
    for (int r = 0; r < 16; ++r) { const int orow = crow(r, hi);
#pragma unroll
        for (int d0 = 0; d0 < 4; ++d0) { const float v = o[d0][r] * rli[r];
            const float vn = __shfl_xor(v, 1);
            if ((r32 & 1) == 0) *(unsigned*)(Ow + (size_t)orow * OS + d0 * 32 + r32) = cvtpk(v, vn); } }
    __syncthreads();
#undef RESC
#undef KBASE
#undef MASKT
#undef HALF_STEP
}
#undef VMW
#undef SLOAD_K
#undef SLOAD_V
#undef SWRITE_K
#undef SWRITE_V
}
DEV att::BlockRef attn_ref(const Args& a, int bh, int qb) {
    const int b = bh >> 3, h = bh & 7;
    att::BlockRef r;
    bf16_t* Q = (bf16_t*)(a.ws + WS_B);
    r.Q = Q + ((size_t)b * SEQ + (size_t)qb * 256) * 1536 + h * 192; r.O = Q + ((size_t)b * SEQ + (size_t)qb * 256) * 1536 + h * 192;
    r.Kn = (const bf16_t*)(a.ws + WS_D) + (size_t)b * LP * 1024 + h * 128; r.Kr = (const bf16_t*)(a.ws + WS_KR) + (size_t)b * LP * 64;
    r.V = (const bf16_t*)(a.ws + WS_A) + (size_t)b * LP * 1024 + h * 128; r.P0 = NMETA + qb * 256;
    return r;
}
DEV void phase_attn(char* lds, const Args& a) {
    const int total = NB * NH * 8, stride = gridDim.x;
    int L = vbid(); if (L >= total) return;
    int pass = 0;
    att::BlockRef cur = attn_ref(a, L >> 3, L & 7);
    att::Seam S;
    att::prime(cur, lds, S);
    for (;;) {
        const bool more_pass = pass == 0, more_item = L + stride < total, last = !more_pass && !more_item;
        int passn = pass + 1, Ln = L;
        if (!more_pass) { passn = 0; Ln = more_item ? L + stride : L; }
        const int yn = Ln & 7;
        const att::BlockRef nxt = last ? cur : attn_ref(a, Ln >> 3, passn ? 15 - yn : yn);
        att::block(cur, nxt, lds, S);
        if (last) break;
        cur = nxt; pass = passn; L = Ln;
    }
}
#endif

DEV void phase_wo_router(char* lds, const Args& a, bool dry = false) {
    const int tid = otid(), lane = tid & 63, wid = tid >> 6, wr = wid >> 2, wc = wid & 3, fr = lane & 15, fq = lane >> 4;
    const bf16_t* O = (const bf16_t*)(a.ws + WS_B); const bf16_t* WOT = (const bf16_t*)(a.ws + WS_WO);
    bf16_t* HB = (bf16_t*)(a.ws + WS_HB); float* RSTD = (float*)(a.ws + WS_RSTD);
    for (int u = blockIdx.x; u < 256; u += gridDim.x) {
        const int t0 = u * 128;
        float ssq[4] = {0.f, 0.f, 0.f, 0.f};
        f32x4 racc[4][3];
#pragma unroll
        for (int m = 0; m < 4; ++m)
#pragma unroll
            for (int n = 0; n < 3; ++n) racc[m][n] = f32x4{0.f, 0.f, 0.f, 0.f};
        const bf16_t* WH = (const bf16_t*)(a.ws + WS_WRT) + 98304; const bf16_t* WL = WH + 49152;
        auto koff = [](int kc) { return (kc >> 1) * 192 + (kc & 1) * 64; };
        auto arow = [&](int r) { return O + (size_t)(t0 + r) * 1536; };
        GtPtrs P = gt_ptrs(arow, [&](int c) { return WOT + (size_t)pcol(c) * 1024; });
        gt_issue2(lds, P, 16, koff);
        bool pre = false;
#pragma unroll 1
        for (int nt = 0; nt < 4; ++nt) {
            f32x4 acc[4][4]; zero_acc(acc);
            gt_run<16>(lds, acc, 16, P, koff, pre);
            f32x4 hh[4][4];
#pragma unroll
            for (int m = 0; m < 4; ++m) { const bf16_t* hr = HB + (size_t)(t0 + wr * 64 + m * 16 + fr) * D + nt * 256 + wc * 64 + fq * 16;
                const u32x4 v0 = *(const u32x4*)hr, v1 = *(const u32x4*)(hr + 8);
                hh[m][0] = f32x4{bflo(v0[0]), bfhi(v0[0]), bflo(v0[1]), bfhi(v0[1])}; hh[m][1] = f32x4{bflo(v0[2]), bfhi(v0[2]), bflo(v0[3]), bfhi(v0[3])};
                hh[m][2] = f32x4{bflo(v1[0]), bfhi(v1[0]), bflo(v1[1]), bfhi(v1[1])}; hh[m][3] = f32x4{bflo(v1[2]), bfhi(v1[2]), bflo(v1[3]), bfhi(v1[3])}; }
            const float sc = dry ? 0.f : 1.f;
#pragma unroll
            for (int m = 0; m < 4; ++m)
#pragma unroll
                for (int n = 0; n < 4; ++n) hh[m][n] += acc[m][n] * sc;
            router_acc(racc, hh, WH, WL, nt * 256 + wc * 64, fr, fq);
#pragma unroll
            for (int m = 0; m < 4; ++m)
#pragma unroll
                for (int n = 0; n < 3; ++n) asm volatile("" : "+v"(racc[m][n]));
            if (nt < 3) { const int n1 = nt + 1; P = gt_ptrs(arow, [&](int c) { return WOT + (size_t)(n1 * 256 + pcol(c)) * 1024; }); gt_issue2(lds, P, 16, koff); }
            pre = true;
#pragma unroll
            for (int m = 0; m < 4; ++m) { const int t = t0 + wr * 64 + m * 16 + fr;
                const int col0 = nt * 256 + wc * 64 + fq * 16;
#pragma unroll
                for (int n = 0; n < 4; ++n) { const f32x4 h = hh[m][n];
                    ssq[m] += h[0] * h[0] + h[1] * h[1] + h[2] * h[2] + h[3] * h[3]; }
                *(u32x4*)(HB + (size_t)t * D + col0) = pk8(hh[m][0], hh[m][1]); *(u32x4*)(HB + (size_t)t * D + col0 + 8) = pk8(hh[m][2], hh[m][3]); }
        }
        const float tot = tile_row_reduce(lds + LDS_RED, ssq);
        if (tid < 128) RSTD[t0 + tid] = rsqrtf(tot * (1.f / D) + EPS);
        router_part_store(lds, racc, wr, wc, fr, fq);
        __syncthreads();
        router_decide(lds, a, 1, t0, 128, dry);
    }
}

DEV void phase_final(const Args& a) {
    const int tid = otid(), lane = tid & 63, wid = tid >> 6;
    const bf16_t* HB = (const bf16_t*)(a.ws + WS_HB); const bf16_t* Y = (const bf16_t*)(a.ws + WS_B);
    for (int t = blockIdx.x * 8 + wid; t < NREAL; t += gridDim.x * 8) {
        f32x4 h[4]; float s = 0.f;
#pragma unroll
        for (int q = 0; q < 4; ++q) { const int col = q * 256 + lane * 4;
            { const u32x2 hb = *(const u32x2*)(HB + (size_t)t * D + col); h[q] = f32x4{bflo(hb[0]), bfhi(hb[0]), bflo(hb[1]), bfhi(hb[1])}; }
            const u32x2 y0 = *(const u32x2*)(Y + (size_t)(2 * t) * D + col), y1 = *(const u32x2*)(Y + (size_t)(2 * t + 1) * D + col);
            h[q][0] += bflo(y0[0]) + bflo(y1[0]); h[q][1] += bfhi(y0[0]) + bfhi(y1[0]); h[q][2] += bflo(y0[1]) + bflo(y1[1]); h[q][3] += bfhi(y0[1]) + bfhi(y1[1]);
            s += h[q][0] * h[q][0] + h[q][1] * h[q][1] + h[q][2] * h[q][2] + h[q][3] * h[q][3]; }
        s = wave_sum(s);
        const float rs = rsqrtf(s * (1.f / D) + EPS);
#pragma unroll
        for (int q = 0; q < 4; ++q) { const int col = q * 256 + lane * 4;
            const f32x4 g = *(const f32x4*)(a.final_norm + col);
            *(f32x4*)(a.out + (size_t)t * D + col) = h[q] * rs * g; }
    }
}


__global__ void __launch_bounds__(NTHR, 2) fwd(Args a) {
    extern __shared__ __attribute__((aligned(16))) char lds[];
    if (threadIdx.x == 0) *(u32x4*)(lds + LDS_XB) = u32x4{0u, 0u, 0u, 0u};
    __syncthreads();
    const bool multi = a.ph_hi - a.ph_lo > 1;
    XcdBarrier bar; bar.bar = (unsigned*)(a.ws + WS_CTL); bar.x = 0; bar.st = (volatile LAS unsigned*)(lds + LDS_XB);
    if (multi) bar = xcd_barrier_post((unsigned*)(a.ws + WS_CTL), (volatile LAS unsigned*)(lds + LDS_XB));
#define PHASE(i, call) if (a.ph_lo <= (i) && (i) < a.ph_hi) { if (a.ph_lo < (i)) xcd_barrier(bar); call; }
    PHASE(0, phase_prologue(lds, a))
    PHASE(1, phase_front(lds, a))
    PHASE(2, phase_moe1(lds, a, 0))
    PHASE(3, phase_moe2(lds, a, 0))
    PHASE(4, phase_comb_latent(lds, a))
    PHASE(5, phase_up(lds, a))
    PHASE(6, { phase_attn(lds, a); __syncthreads(); for (int i = blockIdx.x; i < TR_MOE; i += gridDim.x) tr_moe_job(lds, a, 1, i); })
    PHASE(7, phase_wo_router(lds, a))
    PHASE(8, phase_moe1(lds, a, 1))
    PHASE(9, phase_moe2(lds, a, 1))
    PHASE(10, phase_final(a))
#undef PHASE
}

extern "C" void kernel_launch(void* const* d_in, const int* in_sizes, int n_in, void* d_out, int out_size, void* d_ws, size_t ws_size, hipStream_t stream) {
    (void)in_sizes; (void)n_in; (void)out_size;
    static bool once = false;
    if (!once) { once = true;
        hipError_t e = hipFuncSetAttribute((const void*)fwd, hipFuncAttributeMaxDynamicSharedMemorySize, LDS_BYTES);
        if (e != hipSuccess) fprintf(stderr, "hipFuncSetAttribute: %s\n", hipGetErrorString(e));
        if (ws_size < WS_END) fprintf(stderr, "workspace too small: %zu < %zu\n", ws_size, (size_t)WS_END);
    }
    Args a{};
    const float* const* in = (const float* const*)d_in;
    a.x = in[0]; a.meta = in[1]; a.a_norm = in[2]; a.a_w = in[3]; a.a_scale = in[4];
    a.b_norm = in[5]; a.w_dq = in[6]; a.q_norm = in[7]; a.w_uq = in[8]; a.w_o = in[9];
    a.kv_norm = in[10]; a.w_dkv = in[11]; a.kv_lat_norm = in[12]; a.w_uk = in[13]; a.w_uv = in[14];
    a.ffn_norm = in[15]; a.router_g = in[16]; a.router_g_bias = in[17]; a.router_e = in[18]; a.router_e_bias = in[19];
    a.w_gate = in[20]; a.w_up = in[21]; a.w_down = in[22]; a.final_norm = in[23];
    a.out = (float*)d_out; a.ws = (unsigned char*)d_ws;
    (void)hipMemsetAsync(d_ws, 0, CTL_BYTES, stream);
    static int grid = 0;
    if (!grid) { int dev = 0, cus = 0, per_cu = 0;
        (void)hipGetDevice(&dev); (void)hipDeviceGetAttribute(&cus, hipDeviceAttributeMultiprocessorCount, dev);
        (void)hipOccupancyMaxActiveBlocksPerMultiprocessor(&per_cu, (const void*)fwd, NTHR, LDS_BYTES);
        if (cus <= 0) cus = 256;
        if (per_cu < 1) fprintf(stderr, "occupancy query says %d blocks per CU\n", per_cu);
        grid = cus;
    }
#if ONE_LAUNCH
    a.ph_lo = 0; a.ph_hi = NPHASE;
    hipLaunchKernelGGL(fwd, dim3(grid), dim3(NTHR), LDS_BYTES, stream, a);
#else
    for (int p = 0; p < NPHASE; ++p) { a.ph_lo = p; a.ph_hi = p + 1; hipLaunchKernelGGL(fwd, dim3(grid), dim3(NTHR), LDS_BYTES, stream, a); }
#endif
}
```
